# Optimizing an MI355X kernel written in HIP

```python
import jax, jax.numpy as jnp
from jax import lax
import numpy as np

D_MODEL = 1024
BATCH = 16
SEQ = 256
DEPTH = 2
DEC_BATCH = 4
DEC_SEQ = 2048
PAST_LEN = 256

GRID_W = 64
N_EVEN = (DEPTH + 1) // 2
N_ODD = DEPTH // 2
HEAD_DIM = 64
ATTN_WIDTH = D_MODEL // 2
N_Q_HEADS = ATTN_WIDTH // HEAD_DIM
N_KV_HEADS = N_Q_HEADS // 4
Q_PER_KV = N_Q_HEADS // N_KV_HEADS
KV_WIDTH = N_KV_HEADS * HEAD_DIM
CONV_WIDTH = D_MODEL - ATTN_WIDTH
WINDOW = 128
BLOCK = 128
ROPE_BASE = 10000.0
ROPE_FREQS = HEAD_DIM // 4
ATTN_SCALE = HEAD_DIM ** -0.5
NEG = -1e30
POOL_WIDTH = D_MODEL
POOL_SIZES = (2, 4, 8, 16)
N_POOL_GROUPS = len(POOL_SIZES)
POOL_GROUP = POOL_WIDTH // N_POOL_GROUPS
EPS = 1e-6
EVEN_SIZES = (CONV_WIDTH, CONV_WIDTH, CONV_WIDTH, CONV_WIDTH, ATTN_WIDTH, KV_WIDTH, KV_WIDTH, ATTN_WIDTH)
EVEN_IN = sum(EVEN_SIZES)
EVEN_SPLITS = tuple(int(s) for s in np.cumsum(EVEN_SIZES)[:-1])
ODD_IN = 2 * POOL_WIDTH

kernel_name = "hybrid_diffusion_prefix_conv_swa_pool_step"


def rmsnorm(x, g):
    xf = x.astype(jnp.float32)
    y = xf * lax.rsqrt(jnp.mean(xf * xf, axis=-1, keepdims=True) + EPS)
    return (y * g.astype(jnp.float32)).astype(x.dtype)


def adaln(cond, w, b):
    m = jax.nn.silu(cond) @ w + b
    shift, scale, gate = jnp.split(m, 3, axis=-1)
    return shift[:, None], scale[:, None], gate[:, None]


def modulate(x, g, shift, scale):
    return rmsnorm(x, g) * (1 + scale) + shift


def short_conv(u, w, b):
    up = jnp.pad(u, ((0, 0), (1, 1), (0, 0)))
    return up[:, :-2] * w[0] + up[:, 1:-1] * w[1] + up[:, 2:] * w[2] + b


def axial_rope_tables(n_rows):
    row = jnp.repeat(jnp.arange(n_rows), GRID_W).astype(jnp.float32)
    col = jnp.tile(jnp.arange(GRID_W), n_rows).astype(jnp.float32)
    inv = ROPE_BASE ** (-jnp.arange(ROPE_FREQS, dtype=jnp.float32) / ROPE_FREQS)
    ang = jnp.stack([row[:, None] * inv, col[:, None] * inv], axis=1)
    return jnp.cos(ang), jnp.sin(ang)


def apply_axial_rope(x, cos, sin):
    B, L, H, _ = x.shape
    xr = x.astype(jnp.float32).reshape(B, L, H, 2, 2, ROPE_FREQS)
    x1, x2 = xr[..., 0, :], xr[..., 1, :]
    c, s = cos[None, :, None], sin[None, :, None]
    out = jnp.stack([x1 * c - x2 * s, x2 * c + x1 * s], axis=-2)
    return out.reshape(x.shape).astype(x.dtype)


def sink_softmax(s, sink):
    m = jnp.maximum(jnp.max(s, axis=-1, keepdims=True), sink)
    e = jnp.exp(s - m)
    return e / (jnp.sum(e, axis=-1, keepdims=True) + jnp.exp(sink - m))


def context_attention(q, k, v, sink):
    B, S = q.shape[:2]
    nb = S // BLOCK
    qb = q.reshape(B, nb, BLOCK, N_KV_HEADS, Q_PER_KV, HEAD_DIM).swapaxes(0, 1).astype(jnp.float32)
    kf, vf = k.astype(jnp.float32), v.astype(jnp.float32)
    sk = sink.astype(jnp.float32)[None, :, :, None, None]

    def attend(qblk):
        s = jnp.einsum('bqkgd,bskd->bkgqs', qblk, kf) * ATTN_SCALE
        p = sink_softmax(s, sk)
        return jnp.einsum('bkgqs,bskd->bqkgd', p, vf)

    o = lax.map(attend, qb)
    return o.swapaxes(0, 1).reshape(B, S, ATTN_WIDTH).astype(q.dtype)


def latent_attention(q, k, v, ctx_k, ctx_v, sink):
    B, L = q.shape[:2]
    nb = L // BLOCK
    pad = ((0, 0), (BLOCK, BLOCK), (0, 0), (0, 0))
    kblk = jnp.pad(k, pad).reshape(B, nb + 2, BLOCK, N_KV_HEADS, HEAD_DIM)
    vblk = jnp.pad(v, pad).reshape(B, nb + 2, BLOCK, N_KV_HEADS, HEAD_DIM)
    kb = jnp.concatenate([kblk[:, :-2], kblk[:, 1:-1], kblk[:, 2:]], axis=2).astype(jnp.float32)
    vb = jnp.concatenate([vblk[:, :-2], vblk[:, 1:-1], vblk[:, 2:]], axis=2).astype(jnp.float32)
    qb = q.reshape(B, nb, BLOCK, N_KV_HEADS, Q_PER_KV, HEAD_DIM).astype(jnp.float32)
    qpos = jnp.arange(L).reshape(nb, BLOCK)
    kpos = (jnp.arange(nb)[:, None] - 1) * BLOCK + jnp.arange(3 * BLOCK)[None]
    valid = (jnp.abs(qpos[:, :, None] - kpos[:, None, :]) <= WINDOW) & ((kpos >= 0) & (kpos < L))[:, None, :]
    s_loc = jnp.einsum('bnqkgd,bnskd->bnkgqs', qb, kb) * ATTN_SCALE
    s_loc = jnp.where(valid[None, :, None, None], s_loc, NEG)
    s_ctx = jnp.einsum('bnqkgd,bpkd->bnkgqp', qb, ctx_k.astype(jnp.float32)) * ATTN_SCALE
    p = sink_softmax(jnp.concatenate([s_loc, s_ctx], axis=-1), sink.astype(jnp.float32)[None, None, :, :, None, None])
    o = (jnp.einsum('bnkgqs,bnskd->bnqkgd', p[..., :3 * BLOCK], vb)
         + jnp.einsum('bnkgqp,bpkd->bnqkgd', p[..., 3 * BLOCK:], ctx_v.astype(jnp.float32)))
    return o.reshape(B, L, ATTN_WIDTH).astype(q.dtype)


def even_branches(h, w_in, conv_w, conv_b, q_norm_g, k_norm_g):
    B, L, _ = h.shape
    z = h @ w_in
    bg, cg, xs, ga, q, k, v, gb = jnp.split(z, EVEN_SPLITS, axis=-1)
    ya = bg * short_conv(cg * xs, conv_w, conv_b) * jax.nn.silu(ga)
    q = rmsnorm(q.reshape(B, L, N_Q_HEADS, HEAD_DIM), q_norm_g)
    k = rmsnorm(k.reshape(B, L, N_KV_HEADS, HEAD_DIM), k_norm_g)
    v = v.reshape(B, L, N_KV_HEADS, HEAD_DIM)
    return ya, q, k, v, jax.nn.silu(gb)


def multiscale_pool(u):
    L = u.shape[1]
    uf = u.astype(jnp.float32)
    cs = jnp.pad(jnp.cumsum(uf, axis=1), ((0, 0), (1, 0), (0, 0)))
    t = jnp.arange(L)
    outs = []
    for gi, w in enumerate(POOL_SIZES):
        lo = jnp.clip(t - w // 2, 0, L)
        hi = jnp.clip(t + w // 2, 0, L)
        seg = cs[:, :, gi * POOL_GROUP:(gi + 1) * POOL_GROUP]
        outs.append((seg[:, hi] - seg[:, lo]) / (hi - lo).astype(jnp.float32)[None, :, None])
    return (jnp.concatenate(outs, axis=-1) - uf).astype(u.dtype)


def pool_mixer(h, w_in, pool_w, pool_scale, w_out):
    B, L, _ = h.shape
    u, g = jnp.split(h @ w_in, 2, axis=-1)
    y = multiscale_pool(u).reshape(B, L, N_POOL_GROUPS, POOL_GROUP)
    y = jnp.einsum('blgc,gcd->blgd', y, pool_w).reshape(B, L, POOL_WIDTH) * pool_scale
    return (y * jax.nn.silu(g)) @ w_out


def setup_inputs(seed: int = 0) -> dict:
    key = jax.random.key(seed)
    ks = jax.random.split(key, 24)
    nrm = jax.random.normal
    D = D_MODEL
    return {
        "x_prompt": nrm(ks[0], (BATCH, SEQ, D), jnp.float32),
        "x_sample": nrm(ks[1], (DEC_BATCH, DEC_SEQ, D), jnp.float32),
        "cache_k": nrm(ks[2], (DEC_BATCH, N_EVEN, PAST_LEN, N_KV_HEADS, HEAD_DIM), jnp.float32),
        "cache_v": nrm(ks[3], (DEC_BATCH, N_EVEN, PAST_LEN, N_KV_HEADS, HEAD_DIM), jnp.float32),
        "c": nrm(ks[4], (DEC_BATCH, D), jnp.float32),
        "c_ctx": nrm(ks[5], (D,), jnp.float32),
        "ada_w_e": nrm(ks[6], (N_EVEN, D, 3 * D), jnp.float32) * (0.5 * D ** -0.5),
        "ada_b_e": nrm(ks[7], (N_EVEN, 3 * D), jnp.float32) * 0.01,
        "norm_g_e": 1.0 + 0.01 * nrm(ks[8], (N_EVEN, D), jnp.float32),
        "w_in_e": nrm(ks[9], (N_EVEN, D, EVEN_IN), jnp.float32) * D ** -0.5,
        "conv_w": nrm(ks[10], (N_EVEN, 3, CONV_WIDTH), jnp.float32) * 0.5,
        "conv_b": nrm(ks[11], (N_EVEN, CONV_WIDTH), jnp.float32) * 0.01,
        "q_norm_g": 1.0 + 0.01 * nrm(ks[12], (N_EVEN, HEAD_DIM), jnp.float32),
        "k_norm_g": 1.0 + 0.01 * nrm(ks[13], (N_EVEN, HEAD_DIM), jnp.float32),
        "sink": nrm(ks[14], (N_EVEN, N_Q_HEADS), jnp.float32) * 0.5,
        "w_out_e": nrm(ks[15], (N_EVEN, D, D), jnp.float32) * D ** -0.5,
        "ada_w_o": nrm(ks[16], (N_ODD, D, 3 * D), jnp.float32) * (0.5 * D ** -0.5),
        "ada_b_o": nrm(ks[17], (N_ODD, 3 * D), jnp.float32) * 0.01,
        "norm_g_o": 1.0 + 0.01 * nrm(ks[18], (N_ODD, D), jnp.float32),
        "w_in_o": nrm(ks[19], (N_ODD, D, ODD_IN), jnp.float32) * D ** -0.5,
        "pool_w": nrm(ks[20], (N_ODD, N_POOL_GROUPS, POOL_GROUP, POOL_GROUP), jnp.float32) * POOL_GROUP ** -0.5,
        "pool_scale": 1.0 + 0.1 * nrm(ks[21], (N_ODD, POOL_WIDTH), jnp.float32),
        "w_out_o": nrm(ks[22], (N_ODD, POOL_WIDTH, D), jnp.float32) * POOL_WIDTH ** -0.5,
    }


def reference(x_prompt, x_sample, cache_k, cache_v, c, c_ctx,
              ada_w_e, ada_b_e, norm_g_e, w_in_e, conv_w, conv_b, q_norm_g, k_norm_g, sink, w_out_e,
              ada_w_o, ada_b_o, norm_g_o, w_in_o, pool_w, pool_scale, w_out_o):
    n_rows = x_sample.shape[1] // GRID_W
    cos, sin = axial_rope_tables(n_rows)
    yp, ys = x_prompt, x_sample
    new_k, new_v = [], []
    for layer in range(DEPTH):
        i = layer // 2
        if layer % 2 == 0:
            sp, scp, gp = adaln(c_ctx[None], ada_w_e[i], ada_b_e[i])
            ss, scs, gs = adaln(c, ada_w_e[i], ada_b_e[i])
            snk = sink[i].reshape(N_KV_HEADS, Q_PER_KV)
            hp = modulate(yp, norm_g_e[i], sp, scp)
            ya, q, k, v, gb = even_branches(hp, w_in_e[i], conv_w[i], conv_b[i], q_norm_g[i], k_norm_g[i])
            ob = context_attention(q, k, v, snk)
            yp = yp + gp * (jnp.concatenate([ya, ob * gb], axis=-1) @ w_out_e[i])
            new_k.append(k)
            new_v.append(v)
            hs = modulate(ys, norm_g_e[i], ss, scs)
            ya, q, k, v, gb = even_branches(hs, w_in_e[i], conv_w[i], conv_b[i], q_norm_g[i], k_norm_g[i])
            q = apply_axial_rope(q, cos, sin)
            k = apply_axial_rope(k, cos, sin)
            ob = latent_attention(q, k, v, cache_k[:, i], cache_v[:, i], snk)
            ys = ys + gs * (jnp.concatenate([ya, ob * gb], axis=-1) @ w_out_e[i])
        else:
            sp, scp, gp = adaln(c_ctx[None], ada_w_o[i], ada_b_o[i])
            ss, scs, gs = adaln(c, ada_w_o[i], ada_b_o[i])
            hp = modulate(yp, norm_g_o[i], sp, scp)
            yp = yp + gp * pool_mixer(hp, w_in_o[i], pool_w[i], pool_scale[i], w_out_o[i])
            hs = modulate(ys, norm_g_o[i], ss, scs)
            ys = ys + gs * pool_mixer(hs, w_in_o[i], pool_w[i], pool_scale[i], w_out_o[i])
    new_cache_k = jnp.stack(new_k, axis=1)
    new_cache_v = jnp.stack(new_v, axis=1)
    return (yp, ys, new_cache_k, new_cache_v)
```

```cpp
#include <hip/hip_runtime.h>
#include <hip/hip_cooperative_groups.h>
#include <cstdio>
#include <cstdint>
namespace cg = cooperative_groups;

#ifndef MK_MULTI
#define MK_MULTI 0
#endif
#ifndef PROBE_REPS
#define PROBE_REPS 0
#endif
#ifndef PROBE_PH
#define PROBE_PH -1
#endif
#ifndef PROBE_PREFIX
#define PROBE_PREFIX -1
#endif

#define LAS __attribute__((address_space(3)))
typedef unsigned short bf16_t;
typedef short bf16x8 __attribute__((ext_vector_type(8)));
typedef float f32x4 __attribute__((ext_vector_type(4)));
typedef unsigned u32x4 __attribute__((ext_vector_type(4)));
typedef unsigned u32x2 __attribute__((ext_vector_type(2)));

constexpr int MROWS = 12288, MCTX = 4096, DM = 1024, NE = 3328, NO = 2048;
constexpr float EPSN = 1e-6f, LOG2E = 1.4426950408889634f;
constexpr size_t MiB = 1u << 20;
constexpr size_t WS_ADA = 0, WS_SB = 131072, WS_ROPE = 196608, WS_ROWSS = 262144, WS_BAR = 327680, WS_KC = 524288, WS_VCT = 786432;
constexpr size_t WS_WE = 1 * MiB, WS_WOE = 8 * MiB, WS_WIO = 10 * MiB, WS_PW = 14 * MiB, WS_WOO = 15 * MiB;
constexpr size_t WS_H0 = 18 * MiB, WS_U0 = 42 * MiB, WS_BGA = 54 * MiB, WS_Q = 66 * MiB, WS_K = 78 * MiB, WS_VT = 81 * MiB, WS_SG = 84 * MiB;
constexpr size_t WS_A2 = 96 * MiB, WS_Y1 = 120 * MiB, WS_END = 168 * MiB;
constexpr size_t WS_Y1G = WS_H0, WS_POOLED = WS_H0, WS_U1 = WS_A2, WS_SG2 = WS_U0, WS_A4 = WS_A2;
constexpr int LDS_BYTES = 131072 + 1024;

__device__ __forceinline__ unsigned cvt_pk_bf16(float lo, float hi) { unsigned r; asm volatile("v_cvt_pk_bf16_f32 %0, %1, %2" : "=v"(r) : "v"(lo), "v"(hi)); return r; }
__device__ __forceinline__ float bf_lo(unsigned w) { return __uint_as_float(w << 16); }
__device__ __forceinline__ float bf_hi(unsigned w) { return __uint_as_float(w & 0xffff0000u); }
__device__ __forceinline__ float silu_f(float x) { return x * __builtin_amdgcn_rcpf(1.f + __expf(-x)); }
typedef unsigned u32x2p __attribute__((ext_vector_type(2)));
__device__ __forceinline__ float rowmax4(float x) {
    unsigned xi = __float_as_uint(x); u32x2p r = __builtin_amdgcn_permlane32_swap(xi, xi, false, false);
    const float m = fmaxf(__uint_as_float(r.x), __uint_as_float(r.y)); xi = __float_as_uint(m);
    r = __builtin_amdgcn_permlane16_swap(xi, xi, false, false); return fmaxf(__uint_as_float(r.x), __uint_as_float(r.y));
}
__device__ __forceinline__ float rowsum4(float x) {
    unsigned xi = __float_as_uint(x); u32x2p r = __builtin_amdgcn_permlane32_swap(xi, xi, false, false);
    const float m = __uint_as_float(r.x) + __uint_as_float(r.y); xi = __float_as_uint(m);
    r = __builtin_amdgcn_permlane16_swap(xi, xi, false, false); return __uint_as_float(r.x) + __uint_as_float(r.y);
}
__device__ __forceinline__ void own2line(f32x4& a, f32x4& b) {
#pragma unroll
    for (int i = 0; i < 4; ++i) { unsigned x = __float_as_uint(a[i]), y = __float_as_uint(b[i]);
        u32x2p r = __builtin_amdgcn_permlane16_swap(x, y, false, false); r = __builtin_amdgcn_permlane32_swap(r.x, r.y, false, false);
        a[i] = __uint_as_float(r.x); b[i] = __uint_as_float(r.y); }
}
__device__ __forceinline__ void line2own(f32x4& a, f32x4& b) {
#pragma unroll
    for (int i = 0; i < 4; ++i) { unsigned x = __float_as_uint(a[i]), y = __float_as_uint(b[i]);
        u32x2p r = __builtin_amdgcn_permlane32_swap(x, y, false, false); r = __builtin_amdgcn_permlane16_swap(r.x, r.y, false, false);
        a[i] = __uint_as_float(r.x); b[i] = __uint_as_float(r.y); }
}
__device__ __forceinline__ int cond_of_row(int r) { return r < MCTX ? 0 : 1 + ((r - MCTX) >> 11); }

namespace pg8 {
constexpr int BM = 256, BK = 64, HALF = 128, HTB = HALF * BK * 2, STAGE_BYTES = 8 * HTB, NXCD = 8, WGM = 8;
__device__ __forceinline__ int lds_byte(int r, int c) { const int st = (r >> 4) * 2 + (c >> 5), rr = r & 15, cc = c & 31, ob = rr * 64 + cc * 2; return st * 1024 + (ob ^ (((ob >> 9) & 1) << 5)); }
__device__ __forceinline__ void stage_rc(int b, int& R, int& C) { const int st = b / 1024, sb = b % 1024, swz = sb ^ (((sb >> 9) & 1) << 5); R = (st >> 1) * 16 + swz / 64; C = (st & 1) * 32 + (swz % 64) / 2; }
__device__ __forceinline__ int perm32(int rho) { const int n = rho >> 4, i = rho & 15; return 8 * (i >> 2) + 4 * n + (i & 3); }
struct Unit { int pm, pn; };
struct Gemm { const bf16_t* A; const bf16_t* Bt; int M, N, K, lda, ldb, a_pn_off; };
struct StaticOrder {
    int nM, nN, nwg, G, c;
    __device__ void init(int M, int N, int G_, int c_) { nM = M / BM; nN = N / BM; nwg = nM * nN; G = G_; c = c_; }
    __device__ bool next(int i, Unit& u) const {
        const long L = (long)i * G + c; if (L >= nwg) return false;
        int wgid = (int)L; { const int q = nwg / NXCD, r = nwg % NXCD, xcd = wgid % NXCD, off = wgid / NXCD; wgid = (xcd < r ? xcd * (q + 1) : r * (q + 1) + (xcd - r) * q) + off; }
        const int nig = WGM * nN, gid = wgid / nig, fm = gid * WGM, gsz = (nM - fm) < WGM ? (nM - fm) : WGM;
        u.pm = fm + ((wgid % nig) % gsz); u.pn = (wgid % nig) / gsz; return true;
    }
};
template <class Epi, bool ALIGN_EPI>
__device__ __forceinline__ void gemm_phase(LAS unsigned char* lds, const Gemm g, const StaticOrder& S, const Epi& E) {
    const int tid = threadIdx.x, wid = __builtin_amdgcn_readfirstlane(tid >> 6), lane = tid & 63, wr = wid >> 2, wc = wid & 3, fr = lane & 15, fq = lane >> 4;
    const int K = g.K, nt = K / BK;
    unsigned voffA[2], voffB[2];
#pragma unroll
    for (int i = 0; i < 2; ++i) { int R, C; stage_rc(tid * 16 + i * 8192, R, C); const int Rb = Epi::PERM ? ((R & ~31) + perm32(R & 31)) : R;
        voffA[i] = (unsigned)(R * g.lda + C) * 2u; voffB[i] = (unsigned)(Rb * g.ldb + C) * 2u; }
    const size_t kstep = (size_t)(BK * 2);
    const size_t hstepA = (size_t)HALF * g.lda * 2, hstepB = (size_t)HALF * g.ldb * 2;
    const size_t tstepA = 2 * hstepA, tstepB = 2 * hstepB;
    const unsigned ldsw = (unsigned)wid * 1024u;
    const int aoff = lds_byte(wr * 64 + fr, fq * 8), boff = lds_byte(wc * 32 + fr, fq * 8);
#define PG8_SA(b, h) (((b) * 2 + (h)) * HTB)
#define PG8_SB(b, h) ((4 + (b) * 2 + (h)) * HTB)
#define PG8_STAGE(bufoff, gbase, voff) do { _Pragma("unroll") for (int _i = 0; _i < 2; ++_i) \
        __builtin_amdgcn_global_load_lds((const unsigned*)((const char*)(gbase) + (voff)[_i]), (LAS unsigned*)(lds + (bufoff) + ldsw + _i * 8192), 16, 0, 0); } while (0)
#define PG8_LDA(dst, b, h) do { _Pragma("unroll") for (int m = 0; m < 4; ++m) _Pragma("unroll") for (int k = 0; k < 2; ++k) dst[m][k] = *(const LAS bf16x8*)(lds + PG8_SA(b, h) + aoff + m * 2048 + k * 1024); } while (0)
#define PG8_LDB(dst, b, h) do { _Pragma("unroll") for (int n = 0; n < 2; ++n) _Pragma("unroll") for (int k = 0; k < 2; ++k) dst[n][k] = *(const LAS bf16x8*)(lds + PG8_SB(b, h) + boff + n * 2048 + k * 1024); } while (0)
#define PG8_MMA(ai, bj, At, Bt) do { __builtin_amdgcn_s_setprio(1); _Pragma("unroll") for (int m = 0; m < 4; ++m) _Pragma("unroll") for (int n = 0; n < 2; ++n) _Pragma("unroll") for (int k = 0; k < 2; ++k) \
        acc[ai][bj][m][n] = __builtin_amdgcn_mfma_f32_16x16x32_bf16(Bt[n][k], At[m][k], acc[ai][bj][m][n], 0, 0, 0); __builtin_amdgcn_s_setprio(0); } while (0)
#define PG8_WAIT_V(n) asm volatile("s_waitcnt vmcnt(" #n ")" ::: "memory")
#define PG8_WAIT_L(n) asm volatile("s_waitcnt lgkmcnt(" #n ")" ::: "memory")
#define PG8_BAR __builtin_amdgcn_s_barrier()
#define PG8_SCHED __builtin_amdgcn_sched_barrier(0)
    Unit cur, nxt; int ui = 0;
    if (!S.next(0, cur)) return;
    f32x4 acc[2][2][4][2];
#pragma unroll
    for (int a = 0; a < 2; ++a)
#pragma unroll
        for (int b = 0; b < 2; ++b)
#pragma unroll
            for (int m = 0; m < 4; ++m)
#pragma unroll
                for (int n = 0; n < 2; ++n) acc[a][b][m][n] = (f32x4){0.f, 0.f, 0.f, 0.f};
    bf16x8 At[4][2], B0[2][2], B1[2][2];
    const char* cA = (const char*)g.A + (size_t)cur.pm * tstepA + (size_t)cur.pn * g.a_pn_off; const char* cB = (const char*)g.Bt + (size_t)cur.pn * tstepB;
    PG8_STAGE(PG8_SB(0, 0), cB, voffB); PG8_STAGE(PG8_SB(0, 1), cB + hstepB, voffB); PG8_STAGE(PG8_SA(0, 0), cA, voffA); PG8_STAGE(PG8_SA(0, 1), cA + hstepA, voffA);
    if (wr == 1) PG8_BAR;
    PG8_WAIT_V(2); PG8_BAR;
    PG8_STAGE(PG8_SB(1, 0), cB + kstep, voffB); PG8_STAGE(PG8_SA(1, 0), cA + kstep, voffA); PG8_STAGE(PG8_SB(1, 1), cB + hstepB + kstep, voffB);
    PG8_WAIT_V(6); PG8_BAR;
    for (;;) {
        const bool has_next = S.next(ui + 1, nxt);
        const char* nA = has_next ? (const char*)g.A + (size_t)nxt.pm * tstepA + (size_t)nxt.pn * g.a_pn_off : cA; const char* nB = has_next ? (const char*)g.Bt + (size_t)nxt.pn * tstepB : cB;
#pragma nounroll
        for (int t = 0; t < nt; t += 2) {
            const bool last = (t == nt - 2);
            const char* a1 = cA + (size_t)(t + 1) * kstep;
            const char* a2 = last ? nA : cA + (size_t)(t + 2) * kstep; const char* b2 = last ? nB : cB + (size_t)(t + 2) * kstep;
            const char* a3 = a2 + kstep; const char* b3 = b2 + kstep;
            PG8_LDB(B0, 0, 0); PG8_LDB(B1, 0, 1); PG8_SCHED; PG8_LDA(At, 0, 0); PG8_STAGE(PG8_SA(1, 1), a1 + hstepA, voffA);
            PG8_WAIT_V(8); PG8_WAIT_L(0); PG8_BAR; PG8_MMA(0, 0, At, B0); PG8_MMA(0, 1, At, B1); PG8_BAR; PG8_SCHED;
            PG8_LDA(At, 0, 1); PG8_STAGE(PG8_SB(0, 0), b2, voffB); PG8_STAGE(PG8_SB(0, 1), b2 + hstepB, voffB); PG8_STAGE(PG8_SA(0, 0), a2, voffA);
            PG8_WAIT_V(8); PG8_WAIT_L(0); PG8_BAR; PG8_MMA(1, 0, At, B0); PG8_MMA(1, 1, At, B1); PG8_BAR; PG8_SCHED;
            PG8_LDB(B0, 1, 0); PG8_LDB(B1, 1, 1); PG8_SCHED; PG8_LDA(At, 1, 0); PG8_STAGE(PG8_SA(0, 1), a2 + hstepA, voffA);
            PG8_WAIT_V(8); PG8_WAIT_L(0); PG8_BAR; PG8_MMA(0, 0, At, B0); PG8_MMA(0, 1, At, B1); PG8_BAR; PG8_SCHED;
            PG8_LDA(At, 1, 1); PG8_STAGE(PG8_SB(1, 0), b3, voffB); PG8_STAGE(PG8_SB(1, 1), b3 + hstepB, voffB); PG8_STAGE(PG8_SA(1, 0), a3, voffA);
            PG8_WAIT_V(8); PG8_WAIT_L(0); PG8_BAR; PG8_MMA(1, 0, At, B0); PG8_MMA(1, 1, At, B1); PG8_BAR; PG8_SCHED;
        }
        if constexpr (ALIGN_EPI) { if (wr == 0) PG8_BAR; }
        E(acc, cur, wr, wc, fr, fq);
        if (!has_next) break;
#pragma unroll
        for (int a = 0; a < 2; ++a)
#pragma unroll
            for (int b = 0; b < 2; ++b)
#pragma unroll
                for (int m = 0; m < 4; ++m)
#pragma unroll
                    for (int n = 0; n < 2; ++n) acc[a][b][m][n] = (f32x4){0.f, 0.f, 0.f, 0.f};
        cur = nxt; cA = nA; cB = nB; ++ui;
        if constexpr (ALIGN_EPI) { if (wr == 1) PG8_BAR; }
    }
    PG8_WAIT_V(0);
    if constexpr (!ALIGN_EPI) { if (wr == 0) PG8_BAR; }
    PG8_BAR;
#undef PG8_SA
#undef PG8_SB
#undef PG8_STAGE
#undef PG8_LDA
#undef PG8_LDB
#undef PG8_MMA
#undef PG8_WAIT_V
#undef PG8_WAIT_L
#undef PG8_BAR
#undef PG8_SCHED
}
}

typedef f32x4 Acc[2][2][4][2];

struct EpiE {
    static constexpr bool PERM = true;
    bf16_t *U0, *BGA, *Q, *Kb, *VtC, *VtL, *SG; float *outk, *outv; const float *qg, *kg, *ropeC, *ropeS;
    __device__ __forceinline__ void operator()(const Acc& acc, const pg8::Unit& u, int wr, int wc, int fr, int fq) const {
        asm volatile("" : "+v"(fr), "+v"(fq));
        const int pn = u.pn, row0 = u.pm * 256 + wr * 64 + fr;
        if (pn < 8) {
            bf16_t* dst = (pn < 4 ? U0 : BGA) + (pn & 3) * 128 + wc * 32 + 8 * fq;
#pragma unroll
            for (int ai = 0; ai < 2; ++ai)
#pragma unroll
                for (int m = 0; m < 4; ++m) {
                    const int r = row0 + ai * 128 + m * 16;
                    f32x4 a0 = acc[ai][0][m][0], a1 = acc[ai][0][m][1], b0 = acc[ai][1][m][0], b1 = acc[ai][1][m][1];
                    if (pn >= 4) {
#pragma unroll
                        for (int i = 0; i < 4; ++i) { b0[i] = silu_f(b0[i]); b1[i] = silu_f(b1[i]); }
                    }
                    a0 = a0 * b0; a1 = a1 * b1;
                    u32x4 w; w.x = cvt_pk_bf16(a0[0], a0[1]); w.y = cvt_pk_bf16(a0[2], a0[3]); w.z = cvt_pk_bf16(a1[0], a1[1]); w.w = cvt_pk_bf16(a1[2], a1[3]);
                    *(u32x4*)(dst + (size_t)r * 512) = w;
                }
        } else if (pn < 10 || (pn == 10 && wc < 2)) {
            const bool isq = pn < 10, latent = u.pm >= 16;
            const int head = isq ? 4 * (pn - 8) + wc : wc;
            const float* gam = isq ? qg : kg;
            const float osc = isq ? 0.125f * LOG2E : 1.0f;
#pragma unroll
            for (int ai = 0; ai < 2; ++ai)
#pragma unroll
                for (int m = 0; m < 4; ++m) {
                    const int r = row0 + ai * 128 + m * 16;
                    f32x4 v[2][2]; float ss = 0.f;
#pragma unroll
                    for (int bj = 0; bj < 2; ++bj)
#pragma unroll
                        for (int n = 0; n < 2; ++n) { v[bj][n] = acc[ai][bj][m][n]; ss += (v[bj][n][0] * v[bj][n][0] + v[bj][n][1] * v[bj][n][1]) + (v[bj][n][2] * v[bj][n][2] + v[bj][n][3] * v[bj][n][3]); }
                    ss = rowsum4(ss);
                    const float rs = __builtin_amdgcn_rsqf(ss * (1.f / 64.f) + EPSN);
#pragma unroll
                    for (int bj = 0; bj < 2; ++bj)
#pragma unroll
                        for (int n = 0; n < 2; ++n) v[bj][n] = v[bj][n] * rs * (*(const f32x4*)(gam + 32 * bj + 16 * n + 4 * fq));
                    if (latent) {
                        const int t = (r - MCTX) & 2047;
#pragma unroll
                        for (int bj = 0; bj < 2; ++bj) {
                            const int pos = bj == 0 ? (t >> 6) : (t & 63);
                            const f32x4 cs = *(const f32x4*)(ropeC + pos * 16 + 4 * fq), sn = *(const f32x4*)(ropeS + pos * 16 + 4 * fq);
                            const f32x4 x1 = v[bj][0], x2 = v[bj][1];
                            v[bj][0] = x1 * cs - x2 * sn; v[bj][1] = x2 * cs + x1 * sn;
                        }
                    } else if (!isq) {
                        float* ok = outk + ((size_t)r * 2 + head) * 64 + 4 * fq;
#pragma unroll
                        for (int bj = 0; bj < 2; ++bj)
#pragma unroll
                            for (int n = 0; n < 2; ++n) *(f32x4*)(ok + 32 * bj + 16 * n) = v[bj][n];
                    }
                    bf16_t* dst = isq ? Q + (size_t)r * 512 + head * 64 : Kb + (size_t)r * 128 + head * 64;
#pragma unroll
                    for (int bj = 0; bj < 2; ++bj) {
                        const f32x4 a0 = v[bj][0] * osc, a1 = v[bj][1] * osc;
                        u32x4 w; w.x = cvt_pk_bf16(a0[0], a0[1]); w.y = cvt_pk_bf16(a0[2], a0[3]); w.z = cvt_pk_bf16(a1[0], a1[1]); w.w = cvt_pk_bf16(a1[2], a1[3]);
                        *(u32x4*)(dst + 32 * bj + 8 * fq) = w;
                    }
                    asm volatile("" ::: "memory");
                }
        } else if (pn == 10) {
            const int hv = wc - 2; const bool latent = u.pm >= 16;
#pragma unroll
            for (int ai = 0; ai < 2; ++ai)
#pragma unroll
                for (int m = 0; m < 4; ++m) {
                    const int r = row0 + ai * 128 + m * 16;
                    bf16_t* vt; int L;
                    if (latent) { const int b = (r - MCTX) >> 11, t = (r - MCTX) & 2047; vt = VtL + (size_t)(b * 2 + hv) * 64 * 2048 + (t >> 4) * 1024 + (t & 15); }
                    else { const int b = r >> 8, t = r & 255; vt = VtC + (size_t)(b * 2 + hv) * 64 * 256 + (t >> 4) * 1024 + (t & 15); }
                    L = 16;
#pragma unroll
                    for (int bj = 0; bj < 2; ++bj)
#pragma unroll
                        for (int n = 0; n < 2; ++n) {
                            const f32x4 x = acc[ai][bj][m][n]; const int d0 = 32 * bj + 8 * fq + 4 * n;
                            if (!latent) *(f32x4*)(outv + ((size_t)r * 2 + hv) * 64 + d0) = x;
                            const unsigned p0 = cvt_pk_bf16(x[0], x[1]), p1 = cvt_pk_bf16(x[2], x[3]);
                            vt[(size_t)(d0 + 0) * L] = (bf16_t)(p0 & 0xffffu); vt[(size_t)(d0 + 1) * L] = (bf16_t)(p0 >> 16);
                            vt[(size_t)(d0 + 2) * L] = (bf16_t)(p1 & 0xffffu); vt[(size_t)(d0 + 3) * L] = (bf16_t)(p1 >> 16);
                        }
                    asm volatile("" ::: "memory");
                }
        } else {
            bf16_t* dst = SG + (pn - 11) * 256 + wc * 32 + 8 * fq;
#pragma unroll
            for (int ai = 0; ai < 2; ++ai)
#pragma unroll
                for (int m = 0; m < 4; ++m) {
                    const int r = row0 + ai * 128 + m * 16;
#pragma unroll
                    for (int bj = 0; bj < 2; ++bj) {
                        f32x4 a0 = acc[ai][bj][m][0], a1 = acc[ai][bj][m][1];
#pragma unroll
                        for (int i = 0; i < 4; ++i) { a0[i] = silu_f(a0[i]); a1[i] = silu_f(a1[i]); }
                        u32x4 w; w.x = cvt_pk_bf16(a0[0], a0[1]); w.y = cvt_pk_bf16(a0[2], a0[3]); w.z = cvt_pk_bf16(a1[0], a1[1]); w.w = cvt_pk_bf16(a1[2], a1[3]);
                        *(u32x4*)(dst + (size_t)r * 512 + bj * 128) = w;
                    }
                }
        }
    }
};

struct EpiOut0 {
    static constexpr bool PERM = true;
    const float *xp, *xs, *ada0, *ada1, *g1; bf16_t* Y1; bf16_t* Y1G; float* rowss;
    __device__ __forceinline__ void operator()(const Acc& acc, const pg8::Unit& u, int wr, int wc, int fr, int fq) const {
        asm volatile("" : "+v"(fr), "+v"(fq));
        const int ci = u.pm < 16 ? 0 : 1 + ((u.pm - 16) >> 3);
        const int col0 = u.pn * 256 + wc * 32 + 8 * fq;
        f32x4 gate[2][2], gm[2][2];
#pragma unroll
        for (int bj = 0; bj < 2; ++bj)
#pragma unroll
            for (int n = 0; n < 2; ++n) { const int col = col0 + bj * 128 + n * 4;
                gate[bj][n] = *(const f32x4*)(ada0 + ci * 3072 + 2048 + col);
                gm[bj][n] = *(const f32x4*)(g1 + col) * (*(const f32x4*)(ada1 + ci * 3072 + 1024 + col) + 1.0f); }
#pragma unroll
        for (int ai = 0; ai < 2; ++ai)
#pragma unroll
            for (int m = 0; m < 4; ++m) {
                const int r = u.pm * 256 + ai * 128 + wr * 64 + m * 16 + fr;
                const float* xrow = r < MCTX ? xp + (size_t)r * DM : xs + (size_t)(r - MCTX) * DM;
                float ss = 0.f;
#pragma unroll
                for (int bj = 0; bj < 2; ++bj) { const int col = col0 + bj * 128;
                    f32x4 xa = __builtin_nontemporal_load((const f32x4*)(xrow + col - 4 * fq)), xb = __builtin_nontemporal_load((const f32x4*)(xrow + col - 4 * fq + 16));
                    line2own(xa, xb);
                    const f32x4 y0 = xa + gate[bj][0] * acc[ai][bj][m][0];
                    const f32x4 y1 = xb + gate[bj][1] * acc[ai][bj][m][1];
                    ss += ((y0[0] * y0[0] + y0[1] * y0[1]) + (y0[2] * y0[2] + y0[3] * y0[3])) + ((y1[0] * y1[0] + y1[1] * y1[1]) + (y1[2] * y1[2] + y1[3] * y1[3]));
                    u32x4 wy; wy.x = cvt_pk_bf16(y0[0], y0[1]); wy.y = cvt_pk_bf16(y0[2], y0[3]); wy.z = cvt_pk_bf16(y1[0], y1[1]); wy.w = cvt_pk_bf16(y1[2], y1[3]);
                    *(u32x4*)(Y1 + (size_t)r * DM + col) = wy;
                    const f32x4 g0 = y0 * gm[bj][0], g1v = y1 * gm[bj][1];
                    u32x4 w; w.x = cvt_pk_bf16(g0[0], g0[1]); w.y = cvt_pk_bf16(g0[2], g0[3]); w.z = cvt_pk_bf16(g1v[0], g1v[1]); w.w = cvt_pk_bf16(g1v[2], g1v[3]);
                    *(u32x4*)(Y1G + (size_t)r * DM + col) = w; }
                ss = rowsum4(ss);
                if (fq == 0) atomicAdd(rowss + r, ss);
                asm volatile("" ::: "memory");
            }
    }
};

struct EpiOdd {
    static constexpr bool PERM = true;
    const float *rowss, *sb; bf16_t *U1, *SG2;
    __device__ __forceinline__ void operator()(const Acc& acc, const pg8::Unit& u, int wr, int wc, int fr, int fq) const {
        asm volatile("" : "+v"(fr), "+v"(fq));
        const int ci = u.pm < 16 ? 0 : 1 + ((u.pm - 16) >> 3);
        const int col0 = u.pn * 256 + wc * 32 + 8 * fq;
        f32x4 sbv[2][2];
#pragma unroll
        for (int bj = 0; bj < 2; ++bj)
#pragma unroll
            for (int n = 0; n < 2; ++n) sbv[bj][n] = *(const f32x4*)(sb + ci * NO + col0 + bj * 128 + 4 * n);
        const bool isg = u.pn >= 4;
        bf16_t* dst = isg ? SG2 + (col0 - 1024) : U1 + col0;
#pragma unroll
        for (int ai = 0; ai < 2; ++ai)
#pragma unroll
            for (int m = 0; m < 4; ++m) {
                const int r = u.pm * 256 + ai * 128 + wr * 64 + m * 16 + fr;
                const float rstd = __builtin_amdgcn_rsqf(rowss[r] * (1.f / 1024.f) + EPSN);
#pragma unroll
                for (int bj = 0; bj < 2; ++bj) {
                    f32x4 a0 = acc[ai][bj][m][0] * rstd + sbv[bj][0], a1 = acc[ai][bj][m][1] * rstd + sbv[bj][1];
                    if (isg) {
#pragma unroll
                        for (int i = 0; i < 4; ++i) { a0[i] = silu_f(a0[i]); a1[i] = silu_f(a1[i]); }
                    }
                    u32x4 w; w.x = cvt_pk_bf16(a0[0], a0[1]); w.y = cvt_pk_bf16(a0[2], a0[3]); w.z = cvt_pk_bf16(a1[0], a1[1]); w.w = cvt_pk_bf16(a1[2], a1[3]);
                    *(u32x4*)(dst + (size_t)r * DM + bj * 128) = w;
                }
            }
    }
};

struct EpiPool {
    static constexpr bool PERM = true;
    const float* pscale; const bf16_t* SG2; bf16_t* A4;
    __device__ __forceinline__ void operator()(const Acc& acc, const pg8::Unit& u, int wr, int wc, int fr, int fq) const {
        asm volatile("" : "+v"(fr), "+v"(fq));
        const int col0 = u.pn * 256 + wc * 32 + 8 * fq;
        f32x4 ps[2][2];
#pragma unroll
        for (int bj = 0; bj < 2; ++bj)
#pragma unroll
            for (int n = 0; n < 2; ++n) ps[bj][n] = *(const f32x4*)(pscale + col0 + bj * 128 + 4 * n);
#pragma unroll
        for (int ai = 0; ai < 2; ++ai)
#pragma unroll
            for (int m = 0; m < 4; ++m) {
                const int r = u.pm * 256 + ai * 128 + wr * 64 + m * 16 + fr;
#pragma unroll
                for (int bj = 0; bj < 2; ++bj) {
                    const u32x4 sg = *(const u32x4*)(SG2 + (size_t)r * DM + col0 + bj * 128);
                    f32x4 a0 = acc[ai][bj][m][0] * ps[bj][0], a1 = acc[ai][bj][m][1] * ps[bj][1];
                    a0[0] *= bf_lo(sg.x); a0[1] *= bf_hi(sg.x); a0[2] *= bf_lo(sg.y); a0[3] *= bf_hi(sg.y);
                    a1[0] *= bf_lo(sg.z); a1[1] *= bf_hi(sg.z); a1[2] *= bf_lo(sg.w); a1[3] *= bf_hi(sg.w);
                    u32x4 w; w.x = cvt_pk_bf16(a0[0], a0[1]); w.y = cvt_pk_bf16(a0[2], a0[3]); w.z = cvt_pk_bf16(a1[0], a1[1]); w.w = cvt_pk_bf16(a1[2], a1[3]);
                    *(u32x4*)(A4 + (size_t)r * DM + col0 + bj * 128) = w;
                }
                asm volatile("" ::: "memory");
            }
    }
};

struct EpiFinal {
    static constexpr bool PERM = true;
    const bf16_t* Y1; const float* ada1; float* out;
    __device__ __forceinline__ void operator()(const Acc& acc, const pg8::Unit& u, int wr, int wc, int fr, int fq) const {
        asm volatile("" : "+v"(fr), "+v"(fq));
        const int ci = u.pm < 16 ? 0 : 1 + ((u.pm - 16) >> 3);
        const int col0 = u.pn * 256 + wc * 32 + 8 * fq;
        f32x4 gate[2][2];
#pragma unroll
        for (int bj = 0; bj < 2; ++bj)
#pragma unroll
            for (int n = 0; n < 2; ++n) gate[bj][n] = *(const f32x4*)(ada1 + ci * 3072 + 2048 + col0 + bj * 128 + n * 4);
#pragma unroll
        for (int ai = 0; ai < 2; ++ai)
#pragma unroll
            for (int m = 0; m < 4; ++m) {
                const size_t ro = (size_t)(u.pm * 256 + ai * 128 + wr * 64 + m * 16 + fr) * DM;
#pragma unroll
                for (int bj = 0; bj < 2; ++bj) { const int col = col0 + bj * 128;
                    const u32x4 yb = *(const u32x4*)(Y1 + ro + col);
                    const f32x4 ya = {bf_lo(yb.x), bf_hi(yb.x), bf_lo(yb.y), bf_hi(yb.y)}, yc = {bf_lo(yb.z), bf_hi(yb.z), bf_lo(yb.w), bf_hi(yb.w)};
                    f32x4 oa = ya + gate[bj][0] * acc[ai][bj][m][0], ob = yc + gate[bj][1] * acc[ai][bj][m][1];
                    own2line(oa, ob);
                    __builtin_nontemporal_store(oa, (f32x4*)(out + ro + col - 4 * fq));
                    __builtin_nontemporal_store(ob, (f32x4*)(out + ro + col - 4 * fq + 16)); }
                if (m & 1) asm volatile("" ::: "memory");
            }
    }
};

__device__ __forceinline__ int colmap_e(int np) {
    const int pn = np >> 8, c = np & 255, bj = c >> 7, wc = (c >> 5) & 3, w = c & 31;
    if (pn < 4) return (bj ? 1024 : 512) + pn * 128 + (c & 127);
    if (pn < 8) return (bj ? 1536 : 0) + (pn - 4) * 128 + (c & 127);
    const int fq = w >> 3, n = (w >> 2) & 1, i = w & 3, d = 32 * bj + 16 * n + 4 * fq + i;
    if (pn < 10) return 2048 + (4 * (pn - 8) + wc) * 64 + d;
    if (pn == 10) { if (wc < 2) return 2560 + wc * 64 + d; return 2688 + (wc - 2) * 64 + 32 * bj + w; }
    return 2816 + (pn - 11) * 256 + c;
}
__device__ __forceinline__ unsigned f2bf(float f) { unsigned u = __float_as_uint(f); return (u + 0x7fffu + ((u >> 16) & 1u)) >> 16; }
__device__ __forceinline__ unsigned pk2(float lo, float hi) { return f2bf(lo) | (f2bf(hi) << 16); }
template <bool PERME>
__device__ __forceinline__ void transpose_item(const float* W, int K, int N, bf16_t* WT, int row_off, LAS float* scr, int item, int lane) {
    const int nblk = N / 32, kb = item / nblk, nb = item % nblk, k0 = 64 * kb, n0 = 32 * nb;
    const int srcc = PERME ? colmap_e(n0 + (lane & 31)) : n0 + (lane & 31);
#pragma unroll 8
    for (int i = 0; i < 32; ++i) { const int kk = 2 * i + (lane >> 5); scr[kk * 33 + (lane & 31)] = __builtin_nontemporal_load(W + (size_t)(k0 + kk) * N + srcc); }
    asm volatile("s_waitcnt lgkmcnt(0)" ::: "memory");
    const int c = lane & 7;
#pragma unroll
    for (int j = 0; j < 4; ++j) { const int n = (lane >> 3) + 8 * j; const LAS float* s = scr + (8 * c) * 33 + n;
        u32x4 o; o.x = pk2(s[0 * 33], s[1 * 33]); o.y = pk2(s[2 * 33], s[3 * 33]); o.z = pk2(s[4 * 33], s[5 * 33]); o.w = pk2(s[6 * 33], s[7 * 33]);
        *(u32x4*)(WT + (size_t)(row_off + n0 + n) * K + k0 + 8 * c) = o; }
    asm volatile("s_waitcnt lgkmcnt(0)" ::: "memory");
}
__device__ __forceinline__ void gemv_block(LAS unsigned char* lds, const float* W, int N, int n0, const float* bias, float* out, int out_stride) {
    LAS float* s = (LAS float*)lds; LAS float* red = (LAS float*)(lds + 20480);
    const int tid = threadIdx.x, col = tid & 31, ks = tid >> 5;
    float a[5] = {0.f, 0.f, 0.f, 0.f, 0.f};
    const float* wp = W + (size_t)(ks * 64) * N + n0 + col;
#pragma unroll 16
    for (int k = 0; k < 64; ++k) { const float w = __builtin_nontemporal_load(wp + (size_t)k * N);
#pragma unroll
        for (int ci = 0; ci < 5; ++ci) a[ci] += s[ci * 1024 + ks * 64 + k] * w; }
#pragma unroll
    for (int ci = 0; ci < 5; ++ci) red[(ks * 5 + ci) * 32 + col] = a[ci];
    __syncthreads();
    if (tid < 160) { const int ci = tid >> 5; float t = bias ? bias[n0 + col] : 0.f;
#pragma unroll
        for (int k2 = 0; k2 < 16; ++k2) t += red[(k2 * 5 + ci) * 32 + col];
        __hip_atomic_store(out + ci * out_stride + n0 + col, t, __ATOMIC_RELAXED, __HIP_MEMORY_SCOPE_AGENT); }
    __syncthreads();
}

struct AttnP { const bf16_t *Q, *K, *KC, *VtC, *VtL, *VCt, *SG; bf16_t* A2; const float* sink; };
constexpr int NH = 2;
#define MFMA16(a, b, c) __builtin_amdgcn_mfma_f32_16x16x32_bf16((a), (b), (c), 0, 0, 0)
__device__ __forceinline__ void attn_loadk(bf16x8 (&kf)[2][2], const bf16_t* kb, int k0, int Lk, int c16, int kq) {
#pragma unroll
    for (int kt = 0; kt < 2; ++kt) { int key = k0 + 8 * (c16 >> 2) + 4 * kt + (c16 & 3); key = key < 0 ? 0 : (key > Lk - 1 ? Lk - 1 : key);
#pragma unroll
        for (int ks = 0; ks < 2; ++ks) kf[kt][ks] = *(const bf16x8*)(kb + (size_t)key * 128 + 32 * ks + 8 * kq); }
}
__device__ __forceinline__ void attn_loadv(bf16x8 (&vf)[4], const bf16_t* vb, int k0, int Lk, int c16, int kq) {
    int tok = k0 + 8 * kq; tok = tok < 0 ? 0 : (tok > Lk - 8 ? Lk - 8 : tok);
#pragma unroll
    for (int dt = 0; dt < 4; ++dt) vf[dt] = *(const bf16x8*)(vb + (size_t)(tok >> 4) * 1024 + (16 * dt + c16) * 16 + (tok & 15));
}

__device__ __forceinline__ void rowpair(unsigned& m0, unsigned& m1) {
    u32x2p r = __builtin_amdgcn_permlane32_swap(m0, m1, false, false); m0 = r.x; m1 = r.y;
    r = __builtin_amdgcn_permlane16_swap(m0, m1, false, false); m0 = r.x; m1 = r.y;
}
__device__ __forceinline__ void attn_mask(f32x4& s0, f32x4& s1, int mode, int k0, int Lk, int tq, int kq) {
#pragma unroll
    for (int j = 0; j < 4; ++j) { const int ka = k0 + 8 * kq + j, kb2 = ka + 4; const int da = tq - ka, db = tq - kb2;
        const bool va = mode == 1 && ka >= 0 && ka < Lk && da <= 128 && da >= -128, vb2 = mode == 1 && kb2 >= 0 && kb2 < Lk && db <= 128 && db >= -128;
        s0[j] = va ? s0[j] : -1e30f; s1[j] = vb2 ? s1[j] : -1e30f; }
}
__device__ __forceinline__ void attn_compute(f32x4 (&o)[NH][4], float (&m2)[NH], float (&l)[NH], const bf16x8 (&qf)[NH][2],
                                             const bf16x8 (&kfA)[2][2], const bf16x8 (&vfA)[4], const bf16x8 (&kfB)[2][2], const bf16x8 (&vfB)[4],
                                             int modeA, int k0A, int LkA, int modeB, int k0B, int LkB, int tq, int kq) {
#pragma unroll
    for (int hq = 0; hq < NH; ++hq) {
        const f32x4 z = {0.f, 0.f, 0.f, 0.f};
        f32x4 a0 = MFMA16(kfA[0][0], qf[hq][0], z); a0 = MFMA16(kfA[0][1], qf[hq][1], a0);
        f32x4 a1 = MFMA16(kfA[1][0], qf[hq][0], z); a1 = MFMA16(kfA[1][1], qf[hq][1], a1);
        f32x4 b0 = MFMA16(kfB[0][0], qf[hq][0], z); b0 = MFMA16(kfB[0][1], qf[hq][1], b0);
        f32x4 b1 = MFMA16(kfB[1][0], qf[hq][0], z); b1 = MFMA16(kfB[1][1], qf[hq][1], b1);
        if (modeA) attn_mask(a0, a1, modeA, k0A, LkA, tq, kq);
        if (modeB) attn_mask(b0, b1, modeB, k0B, LkB, tq, kq);
        float mx = fmaxf(fmaxf(fmaxf(fmaxf(a0[0], a0[1]), fmaxf(a0[2], a0[3])), fmaxf(fmaxf(a1[0], a1[1]), fmaxf(a1[2], a1[3]))),
                         fmaxf(fmaxf(fmaxf(b0[0], b0[1]), fmaxf(b0[2], b0[3])), fmaxf(fmaxf(b1[0], b1[1]), fmaxf(b1[2], b1[3]))));
        mx = rowmax4(mx);
        if (__builtin_amdgcn_ballot_w64(mx > m2[hq] + 8.0f) != 0ull) {
            const float mn = fmaxf(m2[hq], mx), alpha = __builtin_amdgcn_exp2f(m2[hq] - mn); m2[hq] = mn; l[hq] *= alpha;
#pragma unroll
            for (int dt = 0; dt < 4; ++dt) o[hq][dt] = o[hq][dt] * alpha;
        }
        const float mr = m2[hq];
        float ps = 0.f;
#pragma unroll
        for (int j = 0; j < 4; ++j) { a0[j] = __builtin_amdgcn_exp2f(a0[j] - mr); a1[j] = __builtin_amdgcn_exp2f(a1[j] - mr); b0[j] = __builtin_amdgcn_exp2f(b0[j] - mr); b1[j] = __builtin_amdgcn_exp2f(b1[j] - mr); }
        ps = ((a0[0] + a0[1]) + (a0[2] + a0[3])) + ((a1[0] + a1[1]) + (a1[2] + a1[3])) + (((b0[0] + b0[1]) + (b0[2] + b0[3])) + ((b1[0] + b1[1]) + (b1[2] + b1[3])));
        l[hq] += ps;
        u32x4 pa, pb; pa.x = cvt_pk_bf16(a0[0], a0[1]); pa.y = cvt_pk_bf16(a0[2], a0[3]); pa.z = cvt_pk_bf16(a1[0], a1[1]); pa.w = cvt_pk_bf16(a1[2], a1[3]);
        pb.x = cvt_pk_bf16(b0[0], b0[1]); pb.y = cvt_pk_bf16(b0[2], b0[3]); pb.z = cvt_pk_bf16(b1[0], b1[1]); pb.w = cvt_pk_bf16(b1[2], b1[3]);
        const bf16x8 pfa = __builtin_bit_cast(bf16x8, pa), pfb = __builtin_bit_cast(bf16x8, pb);
#pragma unroll
        for (int dt = 0; dt < 4; ++dt) { o[hq][dt] = MFMA16(vfA[dt], pfa, o[hq][dt]); o[hq][dt] = MFMA16(vfB[dt], pfb, o[hq][dt]); }
    }
}

__device__ __forceinline__ void attn_unit(LAS unsigned char* lds, const AttnP& P, bool latent, int b, int kvh, int hq0, int q0, int lane, int pflags = 0) {
    const int c16 = lane & 15, kq = lane >> 4;
    const int L = latent ? 2048 : 256;
    const int rowbase = latent ? MCTX + b * 2048 : b * 256;
    const int qrow = rowbase + q0 + c16, tq = q0 + c16;
    bf16x8 qf[NH][2];
#pragma unroll
    for (int hq = 0; hq < NH; ++hq)
#pragma unroll
        for (int ks = 0; ks < 2; ++ks) qf[hq][ks] = *(const bf16x8*)(P.Q + (size_t)qrow * 512 + (4 * kvh + hq0 + hq) * 64 + 32 * ks + 8 * kq);
    u32x2 sgv[NH][4];
#pragma unroll
    for (int hq = 0; hq < NH; ++hq)
#pragma unroll
        for (int dt = 0; dt < 4; ++dt) sgv[hq][dt] = *(const u32x2*)(P.SG + (size_t)qrow * 512 + (4 * kvh + hq0 + hq) * 64 + 16 * dt + 4 * kq);
    f32x4 o[NH][4]; float m2[NH], l[NH];
#pragma unroll
    for (int hq = 0; hq < NH; ++hq) { m2[hq] = P.sink[4 * kvh + hq0 + hq] * LOG2E; l[hq] = kq == 0 ? 1.f : 0.f;
#pragma unroll
        for (int dt = 0; dt < 4; ++dt) o[hq][dt] = (f32x4){0.f, 0.f, 0.f, 0.f}; }
    const bf16_t* Kl = P.K + (size_t)rowbase * 128 + kvh * 64;
    const bf16_t* Vl = latent ? P.VtL + (size_t)(b * 2 + kvh) * 64 * 2048 : P.VtC + (size_t)(b * 2 + kvh) * 64 * 256;
    const bf16_t* Kc = P.KC + (size_t)b * 256 * 128 + kvh * 64;
    const bf16_t* Vc = P.VCt + (size_t)(b * 2 + kvh) * 64 * 256;
    int kloc0, nloc, nh;
    if (latent) { int st_lo = (128 - q0) / 32; if (st_lo < 0 || q0 > 128) st_lo = 0; int st_hi = (2176 - q0 + 31) / 32; if (st_hi > 9) st_hi = 9;
        kloc0 = q0 - 128 + 32 * st_lo; nloc = st_hi - st_lo; nh = nloc + 8; }
    else { kloc0 = 0; nloc = 8; nh = 8; }
    const int nsteps = (nh + 1) >> 1;
#define HSRC(h, kb_, vb_, k0_, Lk_, md_) const int hh_##k0_ = (h) < nh ? (h) : nh - 1; const bool lc_##k0_ = hh_##k0_ < nloc; \
        const bf16_t* kb_ = lc_##k0_ ? Kl : Kc; const bf16_t* vb_ = lc_##k0_ ? Vl : Vc; const int k0_ = lc_##k0_ ? kloc0 + 32 * hh_##k0_ : 32 * (hh_##k0_ - nloc); const int Lk_ = lc_##k0_ ? L : 256; \
        const int md_ = (h) >= nh ? 2 : ((latent && lc_##k0_ && (k0_ < 0 || k0_ + 32 > L || k0_ < q0 - 112 || k0_ + 31 > q0 + 128)) ? 1 : 0)
    bf16x8 kfA[2][2], kfB[2][2], knA[2][2], knB[2][2];
    { HSRC(0, kbA_, vbA_, k0A_, LkA_, mdA_); HSRC(1, kbB_, vbB_, k0B_, LkB_, mdB_); (void)vbA_; (void)vbB_; (void)mdA_; (void)mdB_;
      attn_loadk(kfA, kbA_, k0A_, LkA_, c16, kq); attn_loadk(kfB, kbB_, k0B_, LkB_, c16, kq); }
    for (int st = 0; st < nsteps; ++st) {
        bf16x8 vfA[4], vfB[4];
        HSRC(2 * st, kbA, vbA, k0A, LkA, mdA); HSRC(2 * st + 1, kbB, vbB, k0B, LkB, mdB); (void)kbA; (void)kbB;
        attn_loadv(vfA, vbA, k0A, LkA, c16, kq); attn_loadv(vfB, vbB, k0B, LkB, c16, kq);
        { HSRC(2 * st + 2, kbC, vbC, k0C, LkC, mdC); HSRC(2 * st + 3, kbD, vbD, k0D, LkD, mdD); (void)vbC; (void)vbD; (void)mdC; (void)mdD;
          attn_loadk(knA, kbC, k0C, LkC, c16, kq); attn_loadk(knB, kbD, k0D, LkD, c16, kq); }
        __builtin_amdgcn_sched_barrier(0);
        attn_compute(o, m2, l, qf, kfA, vfA, kfB, vfB, mdA, k0A, LkA, mdB, k0B, LkB, tq, kq);
#pragma unroll
        for (int kt = 0; kt < 2; ++kt) { kfA[kt][0] = knA[kt][0]; kfA[kt][1] = knA[kt][1]; kfB[kt][0] = knB[kt][0]; kfB[kt][1] = knB[kt][1]; }
    }
#undef HSRC
#pragma unroll
    for (int hq = 0; hq < NH; ++hq) {
        const float lt = rowsum4(l[hq]);
        const float inv = 1.f / lt;
        unsigned wx[4], wy[4];
#pragma unroll
        for (int dt = 0; dt < 4; ++dt) {
            const u32x2 sg = sgv[hq][dt];
            const f32x4 v = o[hq][dt] * inv;
            wx[dt] = cvt_pk_bf16(v[0] * bf_lo(sg.x), v[1] * bf_hi(sg.x)); wy[dt] = cvt_pk_bf16(v[2] * bf_lo(sg.y), v[3] * bf_hi(sg.y));
        }
        rowpair(wx[0], wx[1]); rowpair(wy[0], wy[1]); rowpair(wx[2], wx[3]); rowpair(wy[2], wy[3]);
        bf16_t* dst = P.A2 + (size_t)qrow * DM + 512 + (4 * kvh + hq0 + hq) * 64 + 8 * kq;
        if (!(pflags & 8)) { *(u32x4*)dst = (u32x4){wx[0], wy[0], wx[1], wy[1]}; *(u32x4*)(dst + 32) = (u32x4){wx[2], wy[2], wx[3], wy[3]}; }
    }
}

__device__ __forceinline__ void load8(const bf16_t* p, float (&v)[8]) { const u32x4 w = *(const u32x4*)p; v[0] = bf_lo(w.x); v[1] = bf_hi(w.x); v[2] = bf_lo(w.y); v[3] = bf_hi(w.y); v[4] = bf_lo(w.z); v[5] = bf_hi(w.z); v[6] = bf_lo(w.w); v[7] = bf_hi(w.w); }
__device__ __forceinline__ void unpack8(const u32x4 w, float (&v)[8]) { v[0] = bf_lo(w.x); v[1] = bf_hi(w.x); v[2] = bf_lo(w.y); v[3] = bf_hi(w.y); v[4] = bf_lo(w.z); v[5] = bf_hi(w.z); v[6] = bf_lo(w.w); v[7] = bf_hi(w.w); }
__device__ __forceinline__ void store8(bf16_t* p, const float (&v)[8]) { u32x4 w; w.x = cvt_pk_bf16(v[0], v[1]); w.y = cvt_pk_bf16(v[2], v[3]); w.z = cvt_pk_bf16(v[4], v[5]); w.w = cvt_pk_bf16(v[6], v[7]); *(u32x4*)p = w; }
__device__ __forceinline__ void conv_item(const bf16_t* U0, const bf16_t* BGA, bf16_t* A2, const float* cw, const float* cb, int item, int lane) {
    const int c = 8 * lane, r0 = 4 * item;
    const int t0 = r0 < MCTX ? (r0 & 255) : ((r0 - MCTX) & 2047), L = r0 < MCTX ? 256 : 2048;
    u32x4 ur[6], gr[4];
#pragma unroll
    for (int i = 0; i < 6; ++i) { const int t = t0 - 1 + i; const int rr = r0 - 1 + i + (t < 0 ? 1 : 0) - (t >= L ? 1 : 0); ur[i] = *(const u32x4*)(U0 + (size_t)rr * 512 + c); if (t < 0 || t >= L) ur[i] = (u32x4){0u, 0u, 0u, 0u}; }
#pragma unroll
    for (int i = 0; i < 4; ++i) gr[i] = *(const u32x4*)(BGA + (size_t)(r0 + i) * 512 + c);
    float w0[8], w1[8], w2[8], bb[8];
#pragma unroll
    for (int i = 0; i < 8; ++i) { w0[i] = cw[c + i]; w1[i] = cw[512 + c + i]; w2[i] = cw[1024 + c + i]; bb[i] = cb[c + i]; }
#pragma unroll
    for (int i = 0; i < 4; ++i) {
        float pv[8], cu[8], nx[8], g[8], y[8];
        unpack8(ur[i], pv); unpack8(ur[i + 1], cu); unpack8(ur[i + 2], nx); unpack8(gr[i], g);
#pragma unroll
        for (int k = 0; k < 8; ++k) y[k] = g[k] * (w0[k] * pv[k] + w1[k] * cu[k] + w2[k] * nx[k] + bb[k]);
        store8(A2 + (size_t)(r0 + i) * DM + c, y);
    }
}

template <int H>
__device__ __forceinline__ void pool_item_t(const bf16_t* U1, bf16_t* PO, int gi, int chunk, int lane) {
    constexpr int R = 4, NR = R - 1 + 2 * H;
    const int hw = lane >> 5, c = gi * 256 + 8 * (lane & 31), r0 = chunk * (2 * R) + R * hw;
    const int rs = r0 < MCTX ? (r0 & ~255) : MCTX + ((r0 - MCTX) & ~2047), L = r0 < MCTX ? 256 : 2048, t0 = r0 - rs;
    const bf16_t* base = U1 + (size_t)rs * DM + c;
    u32x4 raw[NR];
#pragma unroll
    for (int i = 0; i < NR; ++i) { const int t = t0 - H + i; const int tc = t < 0 ? 0 : (t > L - 1 ? L - 1 : t); raw[i] = *(const u32x4*)(base + (size_t)tc * DM); if (t < 0 || t >= L) raw[i] = (u32x4){0u, 0u, 0u, 0u}; }
    float S[8];
#pragma unroll
    for (int k = 0; k < 8; ++k) S[k] = 0.f;
#pragma unroll
    for (int i = 0; i < 2 * H; ++i) { float v[8]; unpack8(raw[i], v);
#pragma unroll
        for (int k = 0; k < 8; ++k) S[k] += v[k]; }
#pragma unroll
    for (int tt = 0; tt < R; ++tt) {
        const int t = t0 + tt, lo = t - H > 0 ? t - H : 0, hi = t + H < L ? t + H : L;
        const float rc = 1.f / (float)(hi - lo);
        float uc[8], y[8]; unpack8(raw[tt + H], uc);
#pragma unroll
        for (int k = 0; k < 8; ++k) y[k] = S[k] * rc - uc[k];
        store8(PO + (size_t)(rs + t) * DM + c, y);
        if (tt < R - 1) { float va[8], vs[8]; unpack8(raw[tt + 2 * H], va); unpack8(raw[tt], vs);
#pragma unroll
            for (int k = 0; k < 8; ++k) S[k] += va[k] - vs[k]; }
    }
}
__device__ __forceinline__ void pool_item(const bf16_t* U1, bf16_t* PO, int item, int lane, bool direct = false) {
    const int chunk = item >> 2, gi = direct ? (item & 3) : ((item + (item >> 11)) & 3);
    if (gi == 0) pool_item_t<1>(U1, PO, 0, chunk, lane);
    else if (gi == 1) pool_item_t<2>(U1, PO, 1, chunk, lane);
    else if (gi == 2) pool_item_t<4>(U1, PO, 2, chunk, lane);
    else pool_item_t<8>(U1, PO, 3, chunk, lane);
}


#define XB_TMO      128
#define XB_XCNT(j)  (256  + 64 * (j))
#define XB_XSUB(j)  (1280 + 64 * (j))
#define XB_XGEN(j)  (2304 + 64 * (j))
#define XB_TOP      3328
#define XB_TOPGEN   3392
#define XCD_BAR_WORDS 3456
#define XB_SPIN_CAP (1u << 18)
__device__ __forceinline__ unsigned xb_ld(unsigned* p)              { return __hip_atomic_load(p, __ATOMIC_RELAXED, __HIP_MEMORY_SCOPE_AGENT); }
__device__ __forceinline__ unsigned xb_add(unsigned* p, unsigned v) { return __hip_atomic_fetch_add(p, v, __ATOMIC_RELAXED, __HIP_MEMORY_SCOPE_AGENT); }
__device__ __forceinline__ unsigned xb_xcc_id() { return (unsigned)__builtin_amdgcn_s_getreg((3 << 11) | 20) & 0xFu; }
#define XB_SPIN(cond, bar) do { unsigned _sp = 0; while (cond) { __builtin_amdgcn_s_sleep(1); \
    if ((++_sp & 255u) == 0u) { if (xb_ld(&(bar)[XB_TMO])) break; if (_sp > XB_SPIN_CAP) { atomicAdd(&(bar)[XB_TMO], 1u); break; } } } } while (0)
struct XcdBarrier { unsigned* bar; unsigned x; volatile LAS unsigned* st; };
__device__ __forceinline__ XcdBarrier xcd_barrier_post(unsigned* bar, volatile LAS unsigned* st) {
    XcdBarrier b; b.bar = bar; b.x = xb_xcc_id(); b.st = st;
    if (threadIdx.x == 0) (void)xb_add(&bar[XB_XCNT(b.x)], 1u);
    return b;
}
__device__ __forceinline__ void xcd_barrier_complete(unsigned* bar, unsigned x, unsigned& nloc, unsigned& nx) {
    const unsigned G = gridDim.x * gridDim.y * gridDim.z;
    unsigned sum, cnt, mine, sp = 0u;
    for (;;) {
        sum = 0u; cnt = 0u; mine = 0u;
#pragma unroll
        for (unsigned j = 0; j < 16; ++j) { const unsigned c = xb_ld(&bar[XB_XCNT(j)]); sum += c; cnt += (c > 0u) ? 1u : 0u; mine = (j == x) ? c : mine; }
        if (sum == G) break;
        __builtin_amdgcn_s_sleep(1);
        if ((++sp & 255u) == 0u) { if (xb_ld(&bar[XB_TMO])) break; if (sp > XB_SPIN_CAP) { atomicAdd(&bar[XB_TMO], 1u); break; } }
    }
    nloc = mine > 0u ? mine : 1u; nx = cnt > 0u ? cnt : 1u;
}
__device__ __forceinline__ void xcd_barrier(const XcdBarrier& b) {
    asm volatile("s_waitcnt vmcnt(0)" ::: "memory");
    __syncthreads();
    if (threadIdx.x == 0) {
        unsigned* bar = b.bar;
        __builtin_amdgcn_s_waitcnt(0);
        unsigned nloc = b.st[0], nx = b.st[1];
        if (nloc == 0u) { xcd_barrier_complete(bar, b.x, nloc, nx); b.st[0] = nloc; b.st[1] = nx; }
        const unsigned old = xb_add(&bar[XB_XSUB(b.x)], 1u);
        const unsigned gen = old / nloc;
        if (old + 1u == (gen + 1u) * nloc) {
            __builtin_amdgcn_fence(__ATOMIC_RELEASE, "agent");
            asm volatile("s_waitcnt vmcnt(0)" ::: "memory");
            const unsigned og = xb_add(&bar[XB_TOP], 1u);
            const unsigned tg = og / nx;
            if (og + 1u == (tg + 1u) * nx) xb_add(&bar[XB_TOPGEN], 1u);
            else XB_SPIN(xb_ld(&bar[XB_TOPGEN]) == tg, bar);
            __builtin_amdgcn_fence(__ATOMIC_ACQUIRE, "agent");
            xb_add(&bar[XB_XGEN(b.x)], 1u);
            asm volatile("s_waitcnt vmcnt(0)" ::: "memory");
        } else {
            XB_SPIN(xb_ld(&bar[XB_XGEN(b.x)]) == gen, bar);
            __builtin_amdgcn_fence(__ATOMIC_ACQUIRE, "agent");
            asm volatile("s_waitcnt vmcnt(0)" ::: "memory");
        }
    }
    __syncthreads();
}

struct Args { const float* in[23]; float* out; unsigned char* ws; int ph_lo, ph_hi, coop, pad; };
enum { I_XP = 0, I_XS, I_CK, I_CV, I_C, I_CCTX, I_ADAWE, I_ADABE, I_NGE, I_WINE, I_CONVW, I_CONVB, I_QG, I_KG, I_SINK, I_WOUTE, I_ADAWO, I_ADABO, I_NGO, I_WINO, I_POOLW, I_PSCALE, I_WOUTO };

typedef const __attribute__((address_space(4))) Args* KArgs;
__device__ __forceinline__ KArgs opaque_args(KArgs p) { asm volatile("" : "+s"(p)); return p; }
#define WSP(T, off) ((T*)(A->ws + (off)))

__global__ void __launch_bounds__(512) mk_fwd(Args a_) {
    extern __shared__ __attribute__((aligned(16))) unsigned char lds_raw[];
    LAS unsigned char* lds = (LAS unsigned char*)lds_raw;
    cg::grid_group grid = cg::this_grid();
    KArgs ap = (KArgs)__builtin_amdgcn_kernarg_segment_ptr();
    const int G = gridDim.x, bx = blockIdx.x;
    const int lo = ap->ph_lo, hi = ap->ph_hi;
#define TIDS const int tid = threadIdx.x, lane = tid & 63, wave = __builtin_amdgcn_readfirstlane(tid >> 6); (void)lane; (void)wave
#ifndef PHM
#define PHM 0x1ff
#endif
#define IN(k) (((PHM >> (k)) & 1) && lo <= (k) && (k) < hi)
    volatile LAS unsigned* bst = (volatile LAS unsigned*)(lds + 131072);
    if (threadIdx.x < 4) bst[threadIdx.x] = 0u;
    __syncthreads();
    XcdBarrier xbar; xbar.bar = (unsigned*)(ap->ws + WS_BAR); xbar.x = 0; xbar.st = bst;
    if (ap->coop == 1) xbar = xcd_barrier_post((unsigned*)(ap->ws + WS_BAR), bst);
    if (ap->coop == 2) grid.sync();
#define SEAM(k) do { if (IN(k) && IN((k) + 1)) xcd_barrier(xbar); } while (0)

    for (int rep_ = 0, nrep_ = (PROBE_PH == 0 ? 1 + ap->pad : 1); rep_ < nrep_; ++rep_) { if (rep_) xcd_barrier(xbar);
    if (IN(0)) {
        KArgs A = opaque_args(ap); TIDS;
        float* ADA = WSP(float, WS_ADA); float* ROPE = WSP(float, WS_ROPE); float* ROWSS = WSP(float, WS_ROWSS); bf16_t* KC = WSP(bf16_t, WS_KC); bf16_t* VCT = WSP(bf16_t, WS_VCT);
        bf16_t* WE = WSP(bf16_t, WS_WE); bf16_t* WOE = WSP(bf16_t, WS_WOE); bf16_t* WIO = WSP(bf16_t, WS_WIO); bf16_t* PW = WSP(bf16_t, WS_PW); bf16_t* WOO = WSP(bf16_t, WS_WOO);

        const int gt = bx * 512 + tid, NT = G * 512;
        for (int i = gt; i < MROWS; i += NT) ROWSS[i] = 0.f;
        for (int i = gt; i < 131072; i += NT) {
            { const int p = i & 63, bj = p >> 5, w = p & 31, fq = w >> 3, n = (w >> 2) & 1, ii = w & 3, d = 32 * bj + 16 * n + 4 * fq + ii;
              KC[i] = (bf16_t)f2bf(A->in[I_CK][(i & ~63) + d]); }
            { const int t = i & 255, d = (i >> 8) & 63, hv = (i >> 14) & 1, b = i >> 15;
              VCT[(b * 2 + hv) * 16384 + (t >> 4) * 1024 + d * 16 + (t & 15)] = (bf16_t)f2bf(A->in[I_CV][((size_t)(b * 256 + t) * 2 + hv) * 64 + d]); }
        }
        if (bx == G - 1) {
            for (int i = tid; i < 1024; i += 512) { const int pos = i >> 4, f = i & 15;
                const float inv = __builtin_amdgcn_exp2f(-(float)f * (13.287712379549449f / 16.f)); const float ang = (float)pos * inv;
                const float rev = ang * 0.15915494309189535f; const float fr_ = rev - rintf(rev);
                ROPE[i] = __builtin_amdgcn_cosf(fr_); ROPE[1024 + i] = __builtin_amdgcn_sinf(fr_); }
        }
        for (int it = bx; it < 192; it += G) {
            const int l = it / 96, n0 = (it % 96) * 32;
            LAS float* s = (LAS float*)lds;
            for (int i = tid; i < 5120; i += 512) { const int ci = i >> 10, k = i & 1023; const float x = ci == 0 ? A->in[I_CCTX][k] : A->in[I_C][(ci - 1) * 1024 + k]; s[i] = silu_f(x); }
            __syncthreads();
            gemv_block(lds, l == 0 ? A->in[I_ADAWE] : A->in[I_ADAWO], 3072, n0, l == 0 ? A->in[I_ADABE] : A->in[I_ADABO], ADA + l * 15360, 3072);
            asm volatile("s_waitcnt vmcnt(0)" ::: "memory"); __syncthreads();
            if (tid == 0 && l == 0) __hip_atomic_fetch_add((unsigned*)(A->ws + WS_BAR) + 3648, 1u, __ATOMIC_RELAXED, __HIP_MEMORY_SCOPE_AGENT);
        }
        {
            LAS float* scr = (LAS float*)(lds + wave * 16384);
            const int gw = bx * 8 + wave, NGW = G * 8;
            constexpr int I_E = 16 * (NE / 32);
            const bool late = (G == 256);
            constexpr int I_OE = 16 * 32, I_IO = 16 * (NO / 32), I_P = 4 * 32, I_OO = 16 * 32, NIT = I_E + I_OE + I_IO + I_P + I_OO;
            for (int it = gw; it < (late ? I_E : NIT); it += NGW) {
                int r = it;
                if (r < I_E) { transpose_item<true>(A->in[I_WINE], 1024, NE, WE, 0, scr, r, lane); continue; } r -= I_E;
                if (r < I_OE) { transpose_item<false>(A->in[I_WOUTE], 1024, 1024, WOE, 0, scr, r, lane); continue; } r -= I_OE;
                if (r < I_IO) { transpose_item<false>(A->in[I_WINO], 1024, NO, WIO, 0, scr, r, lane); continue; } r -= I_IO;
                if (r < I_P) { const int g4 = r >> 5; transpose_item<false>(A->in[I_POOLW] + (size_t)g4 * 65536, 256, 256, PW, g4 * 256, scr, r & 31, lane); continue; } r -= I_P;
                transpose_item<false>(A->in[I_WOUTO], 1024, 1024, WOO, 0, scr, r, lane);
            }
        }
        __syncthreads();
    }
    }
    if (!((G == 256) && ap->coop == 1)) SEAM(0);
    for (int rep_ = 0, nrep_ = (PROBE_PH == 1 ? 1 + ap->pad : 1); rep_ < nrep_; ++rep_) { if (rep_) xcd_barrier(xbar);
    if (IN(1)) {
        KArgs A = opaque_args(ap); TIDS;
        float* ADA = WSP(float, WS_ADA); float* SB = WSP(float, WS_SB); bf16_t* H0 = WSP(bf16_t, WS_H0);

        for (int it = bx; it < (G == 256 ? 0 : 64); it += G) {
            LAS float* s = (LAS float*)lds;
            for (int i = tid; i < 5120; i += 512) { const int ci = i >> 10, k = i & 1023; s[i] = ADA[15360 + ci * 3072 + k]; }
            __syncthreads();
            gemv_block(lds, A->in[I_WINO], NO, it * 32, nullptr, SB, NO);
        }
        if ((G == 256) && ap->coop == 1) {
            if (tid == 0) { XB_SPIN(xb_ld((unsigned*)(A->ws + WS_BAR) + 3648) < 96u, (unsigned*)(A->ws + WS_BAR)); __builtin_amdgcn_fence(__ATOMIC_ACQUIRE, "agent"); asm volatile("s_waitcnt vmcnt(0)" ::: "memory"); }
            __syncthreads();
        }
        const int gw = bx * 8 + wave, NGW = G * 8;
        for (int r = gw; r < MROWS; r += 2 * NGW) {
            const int r2 = r + NGW < MROWS ? r + NGW : r;
            const float* xa = r < MCTX ? A->in[I_XP] + (size_t)r * DM : A->in[I_XS] + (size_t)(r - MCTX) * DM;
            const float* xb = r2 < MCTX ? A->in[I_XP] + (size_t)r2 * DM : A->in[I_XS] + (size_t)(r2 - MCTX) * DM;
            f32x4 va[4], vb[4]; float sa = 0.f, sb2 = 0.f;
#pragma unroll
            for (int j = 0; j < 4; ++j) { va[j] = __builtin_nontemporal_load((const f32x4*)(xa + 4 * lane + 256 * j)); vb[j] = __builtin_nontemporal_load((const f32x4*)(xb + 4 * lane + 256 * j)); }
#pragma unroll
            for (int j = 0; j < 4; ++j) { sa += (va[j][0] * va[j][0] + va[j][1] * va[j][1]) + (va[j][2] * va[j][2] + va[j][3] * va[j][3]);
                                          sb2 += (vb[j][0] * vb[j][0] + vb[j][1] * vb[j][1]) + (vb[j][2] * vb[j][2] + vb[j][3] * vb[j][3]); }
#pragma unroll
            for (int o = 1; o < 64; o <<= 1) { sa += __shfl_xor(sa, o); sb2 += __shfl_xor(sb2, o); }
            const float rsa = __builtin_amdgcn_rsqf(sa * (1.f / 1024.f) + EPSN), rsb = __builtin_amdgcn_rsqf(sb2 * (1.f / 1024.f) + EPSN);
            const int cia = cond_of_row(r), cib = cond_of_row(r2);
#pragma unroll
            for (int j = 0; j < 4; ++j) { const int k = 4 * lane + 256 * j;
                const f32x4 g = *(const f32x4*)(A->in[I_NGE] + k);
                { const f32x4 sh = *(const f32x4*)(ADA + cia * 3072 + k), sc = *(const f32x4*)(ADA + cia * 3072 + 1024 + k);
                  const f32x4 h = va[j] * rsa * g * (sc + 1.0f) + sh; u32x2 w; w.x = cvt_pk_bf16(h[0], h[1]); w.y = cvt_pk_bf16(h[2], h[3]);
                  *(u32x2*)(H0 + (size_t)r * DM + k) = w; }
                { const f32x4 sh = *(const f32x4*)(ADA + cib * 3072 + k), sc = *(const f32x4*)(ADA + cib * 3072 + 1024 + k);
                  const f32x4 h = vb[j] * rsb * g * (sc + 1.0f) + sh; u32x2 w; w.x = cvt_pk_bf16(h[0], h[1]); w.y = cvt_pk_bf16(h[2], h[3]);
                  *(u32x2*)(H0 + (size_t)r2 * DM + k) = w; }
            }
        }
    }
    }
    SEAM(1);
    for (int rep_ = 0, nrep_ = (PROBE_PH == 2 ? 1 + ap->pad : 1); rep_ < nrep_; ++rep_) { if (rep_) xcd_barrier(xbar);
    if (IN(2)) {
        KArgs A = opaque_args(ap); TIDS;
        float* outk = A->out + (size_t)MROWS * DM; float* outv = outk + 524288; float* ROPE = WSP(float, WS_ROPE);

        pg8::Gemm g{WSP(bf16_t, WS_H0), WSP(bf16_t, WS_WE), MROWS, NE, 1024, 1024, 1024, 0}; pg8::StaticOrder S; S.init(MROWS, NE, G, bx);
        EpiE E{WSP(bf16_t, WS_U0), WSP(bf16_t, WS_BGA), WSP(bf16_t, WS_Q), WSP(bf16_t, WS_K), WSP(bf16_t, WS_VT), WSP(bf16_t, WS_VT + 1 * MiB), WSP(bf16_t, WS_SG), outk, outv, A->in[I_QG], A->in[I_KG], ROPE, ROPE + 1024};
        pg8::gemm_phase<EpiE, true>(lds, g, S, E);
        if (G == 256 && bx >= 112) {
            bf16_t* WOE = WSP(bf16_t, WS_WOE); bf16_t* WIO = WSP(bf16_t, WS_WIO); bf16_t* PW = WSP(bf16_t, WS_PW); bf16_t* WOO = WSP(bf16_t, WS_WOO);
            LAS float* scr = (LAS float*)(lds + wave * 16384);
            constexpr int I_OE = 16 * 32, I_IO = 16 * (NO / 32), I_P = 4 * 32, I_OO = 16 * 32, NIT2 = I_OE + I_IO + I_P + I_OO;
            for (int it = (bx - 112) * 8 + wave; it < NIT2; it += 144 * 8) {
                int r = it;
                if (r < I_OE) { transpose_item<false>(A->in[I_WOUTE], 1024, 1024, WOE, 0, scr, r, lane); continue; } r -= I_OE;
                if (r < I_IO) { transpose_item<false>(A->in[I_WINO], 1024, NO, WIO, 0, scr, r, lane); continue; } r -= I_IO;
                if (r < I_P) { const int g4 = r >> 5; transpose_item<false>(A->in[I_POOLW] + (size_t)g4 * 65536, 256, 256, PW, g4 * 256, scr, r & 31, lane); continue; } r -= I_P;
                transpose_item<false>(A->in[I_WOUTO], 1024, 1024, WOO, 0, scr, r, lane);
            }
        }
    }
    }
    SEAM(2);
    for (int rep_ = 0, nrep_ = (PROBE_PH == 3 ? 1 + (ap->pad & 7) : 1); rep_ < nrep_; ++rep_) { if (rep_) xcd_barrier(xbar);
    if (IN(3)) {
        KArgs A = opaque_args(ap); TIDS;

        AttnP P{WSP(bf16_t, WS_Q), WSP(bf16_t, WS_K), WSP(bf16_t, WS_KC), WSP(bf16_t, WS_VT), WSP(bf16_t, WS_VT + 1 * MiB), WSP(bf16_t, WS_VCT), WSP(bf16_t, WS_SG), WSP(bf16_t, WS_A2), A->in[I_SINK]};
        const int vb = (G % 8 == 0) ? (bx % 8) * (G / 8) + bx / 8 : bx;
        const int part = (PROBE_PH == 3 && rep_) ? (ap->pad >> 8) & 7 : 7, pfl = (PROBE_PH == 3 && rep_) ? (ap->pad >> 8) & 24 : 0;
        if (part & 1) for (int u = vb * 8 + wave; u < 2048; u += G * 8) attn_unit(lds, P, true, u >> 9, (u >> 8) & 1, ((u >> 7) & 1) * 2, (u & 127) * 16, lane, pfl);
        if (wave < 4) { if (part & 2) for (int c = vb * 4 + wave; c < 1024; c += G * 4) attn_unit(lds, P, false, c >> 6, (c >> 5) & 1, ((c >> 4) & 1) * 2, (c & 15) * 16, lane, pfl); }
        else { if (part & 4) for (int it = vb * 4 + (wave - 4); it < 3072; it += G * 4) conv_item(WSP(bf16_t, WS_U0), WSP(bf16_t, WS_BGA), WSP(bf16_t, WS_A2), A->in[I_CONVW], A->in[I_CONVB], it, lane); }
    }
    }
    SEAM(3);
    if (IN(4)) {
        KArgs A = opaque_args(ap); TIDS;
        float* ADA = WSP(float, WS_ADA);

        pg8::Gemm g{WSP(bf16_t, WS_A2), WSP(bf16_t, WS_WOE), MROWS, 1024, 1024, 1024, 1024, 0}; pg8::StaticOrder S; S.init(MROWS, 1024, G, bx);
        EpiOut0 E{A->in[I_XP], A->in[I_XS], ADA, ADA + 15360, A->in[I_NGO], WSP(bf16_t, WS_Y1), WSP(bf16_t, WS_Y1G), WSP(float, WS_ROWSS)};
        pg8::gemm_phase<EpiOut0, true>(lds, g, S, E);
        if (G == 256 && bx >= 192) {
            float* SB = WSP(float, WS_SB);
            LAS float* s = (LAS float*)lds;
            for (int i = tid; i < 5120; i += 512) { const int ci = i >> 10, k = i & 1023; s[i] = ADA[15360 + ci * 3072 + k]; }
            __syncthreads();
            gemv_block(lds, A->in[I_WINO], NO, (bx - 192) * 32, nullptr, SB, NO);
        }
    }
    SEAM(4);
    for (int rep_ = 0, nrep_ = (PROBE_PH == 5 ? 1 + ap->pad : 1); rep_ < nrep_; ++rep_) { if (rep_) xcd_barrier(xbar);
    if (IN(5)) {
        KArgs A = opaque_args(ap); TIDS;

        pg8::Gemm g{WSP(bf16_t, WS_Y1G), WSP(bf16_t, WS_WIO), MROWS, NO, 1024, 1024, 1024, 0}; pg8::StaticOrder S; S.init(MROWS, NO, G, bx);
        EpiOdd E{WSP(float, WS_ROWSS), WSP(float, WS_SB), WSP(bf16_t, WS_U1), WSP(bf16_t, WS_SG2)};
        pg8::gemm_phase<EpiOdd, true>(lds, g, S, E);
    }
    }
    SEAM(5);
    for (int rep_ = 0, nrep_ = (PROBE_PH == 6 ? 1 + ap->pad : 1); rep_ < nrep_; ++rep_) { if (rep_) xcd_barrier(xbar);
    if (IN(6)) {
        KArgs A = opaque_args(ap); TIDS;

        if (G < 192) for (int it = bx * 8 + wave; it < 6144; it += G * 8) pool_item(WSP(bf16_t, WS_U1), WSP(bf16_t, WS_POOLED), it, lane);
    }
    }
    if (G < 192) SEAM(6);
    for (int rep_ = 0, nrep_ = (PROBE_PH == 7 ? 1 + ap->pad : 1); rep_ < nrep_; ++rep_) { if (rep_) xcd_barrier(xbar);
    if (IN(7)) {
        KArgs A = opaque_args(ap); TIDS;

        pg8::Gemm g{WSP(bf16_t, WS_POOLED), WSP(bf16_t, WS_PW), MROWS, 1024, 256, 1024, 256, 512}; pg8::StaticOrder S; S.init(MROWS, 1024, G, bx);
        if (G >= 192) {
            pg8::Unit u0;
            if (S.next(0, u0)) {
                for (int j = wave; j < 32; j += 8) pool_item(WSP(bf16_t, WS_U1), WSP(bf16_t, WS_POOLED), (u0.pm * 32 + j) * 4 + u0.pn, lane, true);
            }
            asm volatile("s_waitcnt vmcnt(0)" ::: "memory");
            __syncthreads();
        }
        EpiPool E{A->in[I_PSCALE], WSP(bf16_t, WS_SG2), WSP(bf16_t, WS_A4)};
        pg8::gemm_phase<EpiPool, true>(lds, g, S, E);
    }
    }
    SEAM(7);
    for (int rep_ = 0, nrep_ = (PROBE_PH == 8 ? 1 + ap->pad : 1); rep_ < nrep_; ++rep_) { if (rep_) xcd_barrier(xbar);
    if (IN(8)) {
        KArgs A = opaque_args(ap); TIDS;

        pg8::Gemm g{WSP(bf16_t, WS_A4), WSP(bf16_t, WS_WOO), MROWS, 1024, 1024, 1024, 1024, 0}; pg8::StaticOrder S; S.init(MROWS, 1024, G, bx);
        EpiFinal E{WSP(bf16_t, WS_Y1), WSP(float, WS_ADA) + 15360, A->out};
        pg8::gemm_phase<EpiFinal, true>(lds, g, S, E);
    }
    }
#ifdef PROBE_SYNC
    for (int q_ = 0; q_ < 8; ++q_) xcd_barrier(xbar);
#endif
#undef IN
#undef SEAM
}

extern "C" void kernel_launch(void* const* d_in, const int* in_sizes, int n_in, void* d_out, int out_size, void* d_ws, size_t ws_size, hipStream_t stream) {
    static int grid = 0;
    if (grid == 0) {
        int dev = 0, cus = 0, per_cu = 0;
        hipGetDevice(&dev);
        hipDeviceGetAttribute(&cus, hipDeviceAttributeMultiprocessorCount, dev);
        if (hipFuncSetAttribute((const void*)mk_fwd, hipFuncAttributeMaxDynamicSharedMemorySize, LDS_BYTES) != hipSuccess) fprintf(stderr, "kernel_launch: hipFuncSetAttribute failed\n");
        if (hipOccupancyMaxActiveBlocksPerMultiprocessor(&per_cu, (const void*)mk_fwd, 512, LDS_BYTES) != hipSuccess || per_cu < 1) { fprintf(stderr, "kernel_launch: occupancy query gave %d\n", per_cu); per_cu = 1; }
        (void)hipGetLastError();
        grid = cus * per_cu; if (grid > 256) grid = 256;
        if (n_in != 23 || ws_size < WS_END) { fprintf(stderr, "kernel_launch: unexpected n_in %d / ws %zu\n", n_in, ws_size); }
    }
    Args a{};
    for (int i = 0; i < 23; ++i) a.in[i] = (const float*)d_in[i];
    a.out = (float*)d_out; a.ws = (unsigned char*)d_ws;
#if MK_MULTI
    for (int ph = 0; ph < 9; ++ph) { a.ph_lo = ph; a.ph_hi = ph + 1; a.coop = 0; hipLaunchKernelGGL(mk_fwd, dim3(grid), dim3(512), LDS_BYTES, stream, a); }
#else
    for (int ph = 0; ph <= PROBE_PREFIX; ++ph) { a.ph_lo = ph; a.ph_hi = ph + 1; a.coop = 0; hipLaunchKernelGGL(mk_fwd, dim3(grid), dim3(512), LDS_BYTES, stream, a); }
    a.ph_lo = 0; a.ph_hi = 9; a.coop = 1; a.pad = PROBE_REPS;
    (void)hipMemsetAsync((char*)d_ws + WS_BAR, 0, 16384, stream);
    void* args[] = {&a};
    hipError_t e = hipLaunchCooperativeKernel((const void*)mk_fwd, dim3(grid), dim3(512), args, LDS_BYTES, stream);
    if (e != hipSuccess) fprintf(stderr, "cooperative launch failed: %s (grid %d)\n", hipGetErrorString(e), grid);
#endif
}
```

```cpp
#include <hip/hip_runtime.h>
#include <hip/hip_cooperative_groups.h>
#include <cstdio>
#include <cstdint>
namespace cg = cooperative_groups;

#ifndef MK_MULTI
#define MK_MULTI 0
#endif
#ifndef PROBE_REPS
#define PROBE_REPS 0
#endif
#ifndef PROBE_PH
#define PROBE_PH -1
#endif
#ifndef PROBE_PREFIX
#define PROBE_PREFIX -1
#endif

#define LAS __attribute__((address_space(3)))
typedef unsigned short bf16_t;
typedef short bf16x8 __attribute__((ext_vector_type(8)));
typedef float f32x4 __attribute__((ext_vector_type(4)));
typedef unsigned u32x4 __attribute__((ext_vector_type(4)));
typedef unsigned u32x2 __attribute__((ext_vector_type(2)));

constexpr int MROWS = 12288, MCTX = 4096, DM = 1024, NE = 3328, NO = 2048;
constexpr float EPSN = 1e-6f, LOG2E = 1.4426950408889634f;
constexpr size_t MiB = 1u << 20;
constexpr size_t WS_ADA = 0, WS_SB = 131072, WS_ROPE = 196608, WS_ROWSS = 262144, WS_BAR = 327680, WS_KC = 524288, WS_VCT = 786432;
constexpr size_t WS_WE = 1 * MiB, WS_WOE = 8 * MiB, WS_WIO = 10 * MiB, WS_PW = 14 * MiB, WS_WOO = 15 * MiB;
constexpr size_t WS_H0 = 18 * MiB, WS_U0 = 42 * MiB, WS_BGA = 54 * MiB, WS_Q = 66 * MiB, WS_K = 78 * MiB, WS_VT = 81 * MiB, WS_SG = 84 * MiB;
constexpr size_t WS_A2 = 96 * MiB, WS_Y1 = 120 * MiB, WS_END = 168 * MiB;
constexpr size_t WS_Y1G = WS_H0, WS_POOLED = WS_H0, WS_U1 = WS_A2, WS_SG2 = WS_U0, WS_A4 = WS_A2;
constexpr int LDS_BYTES = 131072 + 1024;

__device__ __forceinline__ unsigned cvt_pk_bf16(float lo, float hi) { unsigned r; asm volatile("v_cvt_pk_bf16_f32 %0, %1, %2" : "=v"(r) : "v"(lo), "v"(hi)); return r; }
__device__ __forceinline__ float bf_lo(unsigned w) { return __uint_as_float(w << 16); }
__device__ __forceinline__ float bf_hi(unsigned w) { return __uint_as_float(w & 0xffff0000u); }
__device__ __forceinline__ float silu_f(float x) { return x * __builtin_amdgcn_rcpf(1.f + __expf(-x)); }
typedef unsigned u32x2p __attribute__((ext_vector_type(2)));
__device__ __forceinline__ float rowmax4(float x) {
    unsigned xi = __float_as_uint(x); u32x2p r = __builtin_amdgcn_permlane32_swap(xi, xi, false, false);
    const float m = fmaxf(__uint_as_float(r.x), __uint_as_float(r.y)); xi = __float_as_uint(m);
    r = __builtin_amdgcn_permlane16_swap(xi, xi, false, false); return fmaxf(__uint_as_float(r.x), __uint_as_float(r.y));
}
__device__ __forceinline__ float rowsum4(float x) {
    unsigned xi = __float_as_uint(x); u32x2p r = __builtin_amdgcn_permlane32_swap(xi, xi, false, false);
    const float m = __uint_as_float(r.x) + __uint_as_float(r.y); xi = __float_as_uint(m);
    r = __builtin_amdgcn_permlane16_swap(xi, xi, false, false); return __uint_as_float(r.x) + __uint_as_float(r.y);
}
__device__ __forceinline__ void own2line(f32x4& a, f32x4& b) {
#pragma unroll
    for (int i = 0; i < 4; ++i) { unsigned x = __float_as_uint(a[i]), y = __float_as_uint(b[i]);
        u32x2p r = __builtin_amdgcn_permlane16_swap(x, y, false, false); r = __builtin_amdgcn_permlane32_swap(r.x, r.y, false, false);
        a[i] = __uint_as_float(r.x); b[i] = __uint_as_float(r.y); }
}
__device__ __forceinline__ void line2own(f32x4& a, f32x4& b) {
#pragma unroll
    for (int i = 0; i < 4; ++i) { unsigned x = __float_as_uint(a[i]), y = __float_as_uint(b[i]);
        u32x2p r = __builtin_amdgcn_permlane32_swap(x, y, false, false); r = __builtin_amdgcn_permlane16_swap(r.x, r.y, false, false);
        a[i] = __uint_as_float(r.x); b[i] = __uint_as_float(r.y); }
}
__device__ __forceinline__ int cond_of_row(int r) { return r < MCTX ? 0 : 1 + ((r - MCTX) >> 11); }

namespace pg8 {
constexpr int BM = 256, BK = 64, HALF = 128, HTB = HALF * BK * 2, STAGE_BYTES = 8 * HTB, NXCD = 8, WGM = 8;
__device__ __forceinline__ int lds_byte(int r, int c) { const int st = (r >> 4) * 2 + (c >> 5), rr = r & 15, cc = c & 31, ob = rr * 64 + cc * 2; return st * 1024 + (ob ^ (((ob >> 9) & 1) << 5)); }
__device__ __forceinline__ void stage_rc(int b, int& R, int& C) { const int st = b / 1024, sb = b % 1024, swz = sb ^ (((sb >> 9) & 1) << 5); R = (st >> 1) * 16 + swz / 64; C = (st & 1) * 32 + (swz % 64) / 2; }
__device__ __forceinline__ int perm32(int rho) { const int n = rho >> 4, i = rho & 15; return 8 * (i >> 2) + 4 * n + (i & 3); }
struct Unit { int pm, pn; };
struct Gemm { const bf16_t* A; const bf16_t* Bt; int M, N, K, lda, ldb, a_pn_off; };
struct StaticOrder {
    int nM, nN, nwg, G, c;
    __device__ void init(int M, int N, int G_, int c_) { nM = M / BM; nN = N / BM; nwg = nM * nN; G = G_; c = c_; }
    __device__ bool next(int i, Unit& u) const {
        const long L = (long)i * G + c; if (L >= nwg) return false;
        int wgid = (int)L; { const int q = nwg / NXCD, r = nwg % NXCD, xcd = wgid % NXCD, off = wgid / NXCD; wgid = (xcd < r ? xcd * (q + 1) : r * (q + 1) + (xcd - r) * q) + off; }
        const int nig = WGM * nN, gid = wgid / nig, fm = gid * WGM, gsz = (nM - fm) < WGM ? (nM - fm) : WGM;
        u.pm = fm + ((wgid % nig) % gsz); u.pn = (wgid % nig) / gsz; return true;
    }
};
template <class Epi, bool ALIGN_EPI>
__device__ __forceinline__ void gemm_phase(LAS unsigned char* lds, const Gemm g, const StaticOrder& S, const Epi& E) {
    const int tid = threadIdx.x, wid = __builtin_amdgcn_readfirstlane(tid >> 6), lane = tid & 63, wr = wid >> 2, wc = wid & 3, fr = lane & 15, fq = lane >> 4;
    const int K = g.K, nt = K / BK;
    unsigned voffA[2], voffB[2];
#pragma unroll
    for (int i = 0; i < 2; ++i) { int R, C; stage_rc(tid * 16 + i * 8192, R, C); const int Rb = Epi::PERM ? ((R & ~31) + perm32(R & 31)) : R;
        voffA[i] = (unsigned)(R * g.lda + C) * 2u; voffB[i] = (unsigned)(Rb * g.ldb + C) * 2u; }
    const size_t kstep = (size_t)(BK * 2);
    const size_t hstepA = (size_t)HALF * g.lda * 2, hstepB = (size_t)HALF * g.ldb * 2;
    const size_t tstepA = 2 * hstepA, tstepB = 2 * hstepB;
    const unsigned ldsw = (unsigned)wid * 1024u;
    const int aoff = lds_byte(wr * 64 + fr, fq * 8), boff = lds_byte(wc * 32 + fr, fq * 8);
#define PG8_SA(b, h) (((b) * 2 + (h)) * HTB)
#define PG8_SB(b, h) ((4 + (b) * 2 + (h)) * HTB)
#define PG8_STAGE(bufoff, gbase, voff) do { _Pragma("unroll") for (int _i = 0; _i < 2; ++_i) \
        __builtin_amdgcn_global_load_lds((const unsigned*)((const char*)(gbase) + (voff)[_i]), (LAS unsigned*)(lds + (bufoff) + ldsw + _i * 8192), 16, 0, 0); } while (0)
#define PG8_LDA(dst, b, h) do { _Pragma("unroll") for (int m = 0; m < 4; ++m) _Pragma("unroll") for (int k = 0; k < 2; ++k) dst[m][k] = *(const LAS bf16x8*)(lds + PG8_SA(b, h) + aoff + m * 2048 + k * 1024); } while (0)
#define PG8_LDB(dst, b, h) do { _Pragma("unroll") for (int n = 0; n < 2; ++n) _Pragma("unroll") for (int k = 0; k < 2; ++k) dst[n][k] = *(const LAS bf16x8*)(lds + PG8_SB(b, h) + boff + n * 2048 + k * 1024); } while (0)
#define PG8_MMA(ai, bj, At, Bt) do { __builtin_amdgcn_s_setprio(1); _Pragma("unroll") for (int m = 0; m < 4; ++m) _Pragma("unroll") for (int n = 0; n < 2; ++n) _Pragma("unroll") for (int k = 0; k < 2; ++k) \
        acc[ai][bj][m][n] = __builtin_amdgcn_mfma_f32_16x16x32_bf16(Bt[n][k], At[m][k], acc[ai][bj][m][n], 0, 0, 0); __builtin_amdgcn_s_setprio(0); } while (0)
#define PG8_WAIT_V(n) asm volatile("s_waitcnt vmcnt(" #n ")" ::: "memory")
#define PG8_WAIT_L(n) asm volatile("s_waitcnt lgkmcnt(" #n ")" ::: "memory")
#define PG8_BAR __builtin_amdgcn_s_barrier()
#define PG8_SCHED __builtin_amdgcn_sched_barrier(0)
    Unit cur, nxt; int ui = 0;
    if (!S.next(0, cur)) return;
    f32x4 acc[2][2][4][2];
#pragma unroll
    for (int a = 0; a < 2; ++a)
#pragma unroll
        for (int b = 0; b < 2; ++b)
#pragma unroll
            for (int m = 0; m < 4; ++m)
#pragma unroll
                for (int n = 0; n < 2; ++n) acc[a][b][m][n] = (f32x4){0.f, 0.f, 0.f, 0.f};
    bf16x8 At[4][2], B0[2][2], B1[2][2];
    const char* cA = (const char*)g.A + (size_t)cur.pm * tstepA + (size_t)cur.pn * g.a_pn_off; const char* cB = (const char*)g.Bt + (size_t)cur.pn * tstepB;
    PG8_STAGE(PG8_SB(0, 0), cB, voffB); PG8_STAGE(PG8_SB(0, 1), cB + hstepB, voffB); PG8_STAGE(PG8_SA(0, 0), cA, voffA); PG8_STAGE(PG8_SA(0, 1), cA + hstepA, voffA);
    if (wr == 1) PG8_BAR;
    PG8_WAIT_V(2); PG8_BAR;
    PG8_STAGE(PG8_SB(1, 0), cB + kstep, voffB); PG8_STAGE(PG8_SA(1, 0), cA + kstep, voffA); PG8_STAGE(PG8_SB(1, 1), cB + hstepB + kstep, voffB);
    PG8_WAIT_V(6); PG8_BAR;
    for (;;) {
        const bool has_next = S.next(ui + 1, nxt);
        const char* nA = has_next ? (const char*)g.A + (size_t)nxt.pm * tstepA + (size_t)nxt.pn * g.a_pn_off : cA; const char* nB = has_next ? (const char*)g.Bt + (size_t)nxt.pn * tstepB : cB;
#pragma nounroll
        for (int t = 0; t < nt; t += 2) {
            const bool last = (t == nt - 2);
            const char* a1 = cA + (size_t)(t + 1) * kstep;
            const char* a2 = last ? nA : cA + (size_t)(t + 2) * kstep; const char* b2 = last ? nB : cB + (size_t)(t + 2) * kstep;
            const char* a3 = a2 + kstep; const char* b3 = b2 + kstep;
            PG8_LDB(B0, 0, 0); PG8_LDB(B1, 0, 1); PG8_SCHED; PG8_LDA(At, 0, 0); PG8_STAGE(PG8_SA(1, 1), a1 + hstepA, voffA);
            PG8_WAIT_V(8); PG8_WAIT_L(0); PG8_BAR; PG8_MMA(0, 0, At, B0); PG8_MMA(0, 1, At, B1); PG8_BAR; PG8_SCHED;
            PG8_LDA(At, 0, 1); PG8_STAGE(PG8_SB(0, 0), b2, voffB); PG8_STAGE(PG8_SB(0, 1), b2 + hstepB, voffB); PG8_STAGE(PG8_SA(0, 0), a2, voffA);
            PG8_WAIT_V(8); PG8_WAIT_L(0); PG8_BAR; PG8_MMA(1, 0, At, B0); PG8_MMA(1, 1, At, B1); PG8_BAR; PG8_SCHED;
            PG8_LDB(B0, 1, 0); PG8_LDB(B1, 1, 1); PG8_SCHED; PG8_LDA(At, 1, 0); PG8_STAGE(PG8_SA(0, 1), a2 + hstepA, voffA);
            PG8_WAIT_V(8); PG8_WAIT_L(0); PG8_BAR; PG8_MMA(0, 0, At, B0); PG8_MMA(0, 1, At, B1); PG8_BAR; PG8_SCHED;
            PG8_LDA(At, 1, 1); PG8_STAGE(PG8_SB(1, 0), b3, voffB); PG8_STAGE(PG8_SB(1, 1), b3 + hstepB, voffB); PG8_STAGE(PG8_SA(1, 0), a3, voffA);
            PG8_WAIT_V(8); PG8_WAIT_L(0); PG8_BAR; PG8_MMA(1, 0, At, B0); PG8_MMA(1, 1, At, B1); PG8_BAR; PG8_SCHED;
        }
        if constexpr (ALIGN_EPI) { if (wr == 0) PG8_BAR; }
        E(acc, cur, wr, wc, fr, fq);
        if (!has_next) break;
#pragma unroll
        for (int a = 0; a < 2; ++a)
#pragma unroll
            for (int b = 0; b < 2; ++b)
#pragma unroll
                for (int m = 0; m < 4; ++m)
#pragma unroll
                    for (int n = 0; n < 2; ++n) acc[a][b][m][n] = (f32x4){0.f, 0.f, 0.f, 0.f};
        cur = nxt; cA = nA; cB = nB; ++ui;
        if constexpr (ALIGN_EPI) { if (wr == 1) PG8_BAR; }
    }
    PG8_WAIT_V(0);
    if constexpr (!ALIGN_EPI) { if (wr == 0) PG8_BAR; }
    PG8_BAR;
#undef PG8_SA
#undef PG8_SB
#undef PG8_STAGE
#undef PG8_LDA
#undef PG8_LDB
#undef PG8_MMA
#undef PG8_WAIT_V
#undef PG8_WAIT_L
#undef PG8_BAR
#undef PG8_SCHED
}
}

typedef f32x4 Acc[2][2][4][2];

struct EpiE {
    static constexpr bool PERM = true;
    bf16_t *U0, *BGA, *Q, *Kb, *VtC, *VtL, *SG; float *outk, *outv; const float *qg, *kg, *ropeC, *ropeS;
    __device__ __forceinline__ void operator()(const Acc& acc, const pg8::Unit& u, int wr, int wc, int fr, int fq) const {
        asm volatile("" : "+v"(fr), "+v"(fq));
        const int pn = u.pn, row0 = u.pm * 256 + wr * 64 + fr;
        if (pn < 8) {
            bf16_t* dst = (pn < 4 ? U0 : BGA) + (pn & 3) * 128 + wc * 32 + 8 * fq;
#pragma unroll
            for (int ai = 0; ai < 2; ++ai)
#pragma unroll
                for (int m = 0; m < 4; ++m) {
                    const int r = row0 + ai * 128 + m * 16;
                    f32x4 a0 = acc[ai][0][m][0], a1 = acc[ai][0][m][1], b0 = acc[ai][1][m][0], b1 = acc[ai][1][m][1];
                    if (pn >= 4) {
#pragma unroll
                        for (int i = 0; i < 4; ++i) { b0[i] = silu_f(b0[i]); b1[i] = silu_f(b1[i]); }
                    }
                    a0 = a0 * b0; a1 = a1 * b1;
                    u32x4 w; w.x = cvt_pk_bf16(a0[0], a0[1]); w.y = cvt_pk_bf16(a0[2], a0[3]); w.z = cvt_pk_bf16(a1[0], a1[1]); w.w = cvt_pk_bf16(a1[2], a1[3]);
                    *(u32x4*)(dst + (size_t)r * 512) = w;
                }
        } else if (pn < 10 || (pn == 10 && wc < 2)) {
            const bool isq = pn < 10, latent = u.pm >= 16;
            const int head = isq ? 4 * (pn - 8) + wc : wc;
            const float* gam = isq ? qg : kg;
            const float osc = isq ? 0.125f * LOG2E : 1.0f;
#pragma unroll
            for (int ai = 0; ai < 2; ++ai)
#pragma unroll
                for (int m = 0; m < 4; ++m) {
                    const int r = row0 + ai * 128 + m * 16;
                    f32x4 v[2][2]; float ss = 0.f;
#pragma unroll
                    for (int bj = 0; bj < 2; ++bj)
#pragma unroll
                        for (int n = 0; n < 2; ++n) { v[bj][n] = acc[ai][bj][m][n]; ss += (v[bj][n][0] * v[bj][n][0] + v[bj][n][1] * v[bj][n][1]) + (v[bj][n][2] * v[bj][n][2] + v[bj][n][3] * v[bj][n][3]); }
                    ss = rowsum4(ss);
                    const float rs = __builtin_amdgcn_rsqf(ss * (1.f / 64.f) + EPSN);
#pragma unroll
                    for (int bj = 0; bj < 2; ++bj)
#pragma unroll
                        for (int n = 0; n < 2; ++n) v[bj][n] = v[bj][n] * rs * (*(const f32x4*)(gam + 32 * bj + 16 * n + 4 * fq));
                    if (latent) {
                        const int t = (r - MCTX) & 2047;
#pragma unroll
                        for (int bj = 0; bj < 2; ++bj) {
                            const int pos = bj == 0 ? (t >> 6) : (t & 63);
                            const f32x4 cs = *(const f32x4*)(ropeC + pos * 16 + 4 * fq), sn = *(const f32x4*)(ropeS + pos * 16 + 4 * fq);
                            const f32x4 x1 = v[bj][0], x2 = v[bj][1];
                            v[bj][0] = x1 * cs - x2 * sn; v[bj][1] = x2 * cs + x1 * sn;
                        }
                    } else if (!isq) {
                        float* ok = outk + ((size_t)r * 2 + head) * 64 + 4 * fq;
#pragma unroll
                        for (int bj = 0; bj < 2; ++bj)
#pragma unroll
                            for (int n = 0; n < 2; ++n) *(f32x4*)(ok + 32 * bj + 16 * n) = v[bj][n];
                    }
                    bf16_t* dst = isq ? Q + (size_t)r * 512 + head * 64 : Kb + (size_t)r * 128 + head * 64;
#pragma unroll
                    for (int bj = 0; bj < 2; ++bj) {
                        const f32x4 a0 = v[bj][0] * osc, a1 = v[bj][1] * osc;
                        u32x4 w; w.x = cvt_pk_bf16(a0[0], a0[1]); w.y = cvt_pk_bf16(a0[2], a0[3]); w.z = cvt_pk_bf16(a1[0], a1[1]); w.w = cvt_pk_bf16(a1[2], a1[3]);
                        *(u32x4*)(dst + 32 * bj + 8 * fq) = w;
                    }
                    asm volatile("" ::: "memory");
                }
        } else if (pn == 10) {
            const int hv = wc - 2; const bool latent = u.pm >= 16;
#pragma unroll
            for (int ai = 0; ai < 2; ++ai)
#pragma unroll
                for (int m = 0; m < 4; ++m) {
                    const int r = row0 + ai * 128 + m * 16;
                    bf16_t* vt; int L;
                    if (latent) { const int b = (r - MCTX) >> 11, t = (r - MCTX) & 2047; vt = VtL + (size_t)(b * 2 + hv) * 64 * 2048 + (t >> 4) * 1024 + (t & 15); }
                    else { const int b = r >> 8, t = r & 255; vt = VtC + (size_t)(b * 2 + hv) * 64 * 256 + (t >> 4) * 1024 + (t & 15); }
                    L = 16;
#pragma unroll
                    for (int bj = 0; bj < 2; ++bj)
#pragma unroll
                        for (int n = 0; n < 2; ++n) {
                            const f32x4 x = acc[ai][bj][m][n]; const int d0 = 32 * bj + 8 * fq + 4 * n;
                            if (!latent) *(f32x4*)(outv + ((size_t)r * 2 + hv) * 64 + d0) = x;
                            const unsigned p0 = cvt_pk_bf16(x[0], x[1]), p1 = cvt_pk_bf16(x[2], x[3]);
                            vt[(size_t)(d0 + 0) * L] = (bf16_t)(p0 & 0xffffu); vt[(size_t)(d0 + 1) * L] = (bf16_t)(p0 >> 16);
                            vt[(size_t)(d0 + 2) * L] = (bf16_t)(p1 & 0xffffu); vt[(size_t)(d0 + 3) * L] = (bf16_t)(p1 >> 16);
                        }
                    asm volatile("" ::: "memory");
                }
        } else {
            bf16_t* dst = SG + (pn - 11) * 256 + wc * 32 + 8 * fq;
#pragma unroll
            for (int ai = 0; ai < 2; ++ai)
#pragma unroll
                for (int m = 0; m < 4; ++m) {
                    const int r = row0 + ai * 128 + m * 16;
#pragma unroll
                    for (int bj = 0; bj < 2; ++bj) {
                        f32x4 a0 = acc[ai][bj][m][0], a1 = acc[ai][bj][m][1];
#pragma unroll
                        for (int i = 0; i < 4; ++i) { a0[i] = silu_f(a0[i]); a1[i] = silu_f(a1[i]); }
                        u32x4 w; w.x = cvt_pk_bf16(a0[0], a0[1]); w.y = cvt_pk_bf16(a0[2], a0[3]); w.z = cvt_pk_bf16(a1[0], a1[1]); w.w = cvt_pk_bf16(a1[2], a1[3]);
                        *(u32x4*)(dst + (size_t)r * 512 + bj * 128) = w;
                    }
                }
        }
    }
};

struct EpiOut0 {
    static constexpr bool PERM = true;
    const float *xp, *xs, *ada0, *ada1, *g1; bf16_t* Y1; bf16_t* Y1G; float* rowss;
    __device__ __forceinline__ void operator()(const Acc& acc, const pg8::Unit& u, int wr, int wc, int fr, int fq) const {
        asm volatile("" : "+v"(fr), "+v"(fq));
        const int ci = u.pm < 16 ? 0 : 1 + ((u.pm - 16) >> 3);
        const int col0 = u.pn * 256 + wc * 32 + 8 * fq;
        f32x4 gate[2][2], gm[2][2];
#pragma unroll
        for (int bj = 0; bj < 2; ++bj)
#pragma unroll
            for (int n = 0; n < 2; ++n) { const int col = col0 + bj * 128 + n * 4;
                gate[bj][n] = *(const f32x4*)(ada0 + ci * 3072 + 2048 + col);
                gm[bj][n] = *(const f32x4*)(g1 + col) * (*(const f32x4*)(ada1 + ci * 3072 + 1024 + col) + 1.0f); }
#pragma unroll
        for (int ai = 0; ai < 2; ++ai)
#pragma unroll
            for (int m = 0; m < 4; ++m) {
                const int r = u.pm * 256 + ai * 128 + wr * 64 + m * 16 + fr;
                const float* xrow = r < MCTX ? xp + (size_t)r * DM : xs + (size_t)(r - MCTX) * DM;
                float ss = 0.f;
#pragma unroll
                for (int bj = 0; bj < 2; ++bj) { const int col = col0 + bj * 128;
                    f32x4 xa = __builtin_nontemporal_load((const f32x4*)(xrow + col - 4 * fq)), xb = __builtin_nontemporal_load((const f32x4*)(xrow + col - 4 * fq + 16));
                    line2own(xa, xb);
                    const f32x4 y0 = xa + gate[bj][0] * acc[ai][bj][m][0];
                    const f32x4 y1 = xb + gate[bj][1] * acc[ai][bj][m][1];
                    ss += ((y0[0] * y0[0] + y0[1] * y0[1]) + (y0[2] * y0[2] + y0[3] * y0[3])) + ((y1[0] * y1[0] + y1[1] * y1[1]) + (y1[2] * y1[2] + y1[3] * y1[3]));
                    u32x4 wy; wy.x = cvt_pk_bf16(y0[0], y0[1]); wy.y = cvt_pk_bf16(y0[2], y0[3]); wy.z = cvt_pk_bf16(y1[0], y1[1]); wy.w = cvt_pk_bf16(y1[2], y1[3]);
                    *(u32x4*)(Y1 + (size_t)r * DM + col) = wy;
                    const f32x4 g0 = y0 * gm[bj][0], g1v = y1 * gm[bj][1];
                    u32x4 w; w.x = cvt_pk_bf16(g0[0], g0[1]); w.y = cvt_pk_bf16(g0[2], g0[3]); w.z = cvt_pk_bf16(g1v[0], g1v[1]); w.w = cvt_pk_bf16(g1v[2], g1v[3]);
                    *(u32x4*)(Y1G + (size_t)r * DM + col) = w; }
                ss = rowsum4(ss);
                if (fq == 0) atomicAdd(rowss + r, ss);
                asm volatile("" ::: "memory");
            }
    }
};

struct EpiOdd {
    static constexpr bool PERM = true;
    const float *rowss, *sb; bf16_t *U1, *SG2;
    __device__ __forceinline__ void operator()(const Acc& acc, const pg8::Unit& u, int wr, int wc, int fr, int fq) const {
        asm volatile("" : "+v"(fr), "+v"(fq));
        const int ci = u.pm < 16 ? 0 : 1 + ((u.pm - 16) >> 3);
        const int col0 = u.pn * 256 + wc * 32 + 8 * fq;
        f32x4 sbv[2][2];
#pragma unroll
        for (int bj = 0; bj < 2; ++bj)
#pragma unroll
            for (int n = 0; n < 2; ++n) sbv[bj][n] = *(const f32x4*)(sb + ci * NO + col0 + bj * 128 + 4 * n);
        const bool isg = u.pn >= 4;
        bf16_t* dst = isg ? SG2 + (col0 - 1024) : U1 + col0;
#pragma unroll
        for (int ai = 0; ai < 2; ++ai)
#pragma unroll
            for (int m = 0; m < 4; ++m) {
                const int r = u.pm * 256 + ai * 128 + wr * 64 + m * 16 + fr;
                const float rstd = __builtin_amdgcn_rsqf(rowss[r] * (1.f / 1024.f) + EPSN);
#pragma unroll
                for (int bj = 0; bj < 2; ++bj) {
                    f32x4 a0 = acc[ai][bj][m][0] * rstd + sbv[bj][0], a1 = acc[ai][bj][m][1] * rstd + sbv[bj][1];
                    if (isg) {
#pragma unroll
                        for (int i = 0; i < 4; ++i) { a0[i] = silu_f(a0[i]); a1[i] = silu_f(a1[i]); }
                    }
                    u32x4 w; w.x = cvt_pk_bf16(a0[0], a0[1]); w.y = cvt_pk_bf16(a0[2], a0[3]); w.z = cvt_pk_bf16(a1[0], a1[1]); w.w = cvt_pk_bf16(a1[2], a1[3]);
                    *(u32x4*)(dst + (size_t)r * DM + bj * 128) = w;
                }
            }
    }
};

struct EpiPool {
    static constexpr bool PERM = true;
    const float* pscale; const bf16_t* SG2; bf16_t* A4;
    __device__ __forceinline__ void operator()(const Acc& acc, const pg8::Unit& u, int wr, int wc, int fr, int fq) const {
        asm volatile("" : "+v"(fr), "+v"(fq));
        const int col0 = u.pn * 256 + wc * 32 + 8 * fq;
        f32x4 ps[2][2];
#pragma unroll
        for (int bj = 0; bj < 2; ++bj)
#pragma unroll
            for (int n = 0; n < 2; ++n) ps[bj][n] = *(const f32x4*)(pscale + col0 + bj * 128 + 4 * n);
#pragma unroll
        for (int ai = 0; ai < 2; ++ai)
#pragma unroll
            for (int m = 0; m < 4; ++m) {
                const int r = u.pm * 256 + ai * 128 + wr * 64 + m * 16 + fr;
#pragma unroll
                for (int bj = 0; bj < 2; ++bj) {
                    const u32x4 sg = *(const u32x4*)(SG2 + (size_t)r * DM + col0 + bj * 128);
                    f32x4 a0 = acc[ai][bj][m][0] * ps[bj][0], a1 = acc[ai][bj][m][1] * ps[bj][1];
                    a0[0] *= bf_lo(sg.x); a0[1] *= bf_hi(sg.x); a0[2] *= bf_lo(sg.y); a0[3] *= bf_hi(sg.y);
                    a1[0] *= bf_lo(sg.z); a1[1] *= bf_hi(sg.z); a1[2] *= bf_lo(sg.w); a1[3] *= bf_hi(sg.w);
                    u32x4 w; w.x = cvt_pk_bf16(a0[0], a0[1]); w.y = cvt_pk_bf16(a0[2], a0[3]); w.z = cvt_pk_bf16(a1[0], a1[1]); w.w = cvt_pk_bf16(a1[2], a1[3]);
                    *(u32x4*)(A4 + (size_t)r * DM + col0 + bj * 128) = w;
                }
                asm volatile("" ::: "memory");
            }
    }
};

struct EpiFinal {
    static constexpr bool PERM = true;
    const bf16_t* Y1; const float* ada1; float* out;
    __device__ __forceinline__ void operator()(const Acc& acc, const pg8::Unit& u, int wr, int wc, int fr, int fq) const {
        asm volatile("" : "+v"(fr), "+v"(fq));
        const int ci = u.pm < 16 ? 0 : 1 + ((u.pm - 16) >> 3);
        const int col0 = u.pn * 256 + wc * 32 + 8 * fq;
        f32x4 gate[2][2];
#pragma unroll
        for (int bj = 0; bj < 2; ++bj)
#pragma unroll
            for (int n = 0; n < 2; ++n) gate[bj][n] = *(const f32x4*)(ada1 + ci * 3072 + 2048 + col0 + bj * 128 + n * 4);
#pragma unroll
        for (int ai = 0; ai < 2; ++ai)
#pragma unroll
            for (int m = 0; m < 4; ++m) {
                const size_t ro = (size_t)(u.pm * 256 + ai * 128 + wr * 64 + m * 16 + fr) * DM;
#pragma unroll
                for (int bj = 0; bj < 2; ++bj) { const int col = col0 + bj * 128;
                    const u32x4 yb = *(const u32x4*)(Y1 + ro + col);
                    const f32x4 ya = {bf_lo(yb.x), bf_hi(yb.x), bf_lo(yb.y), bf_hi(yb.y)}, yc = {bf_lo(yb.z), bf_hi(yb.z), bf_lo(yb.w), bf_hi(yb.w)};
                    f32x4 oa = ya + gate[bj][0] * acc[ai][bj][m][0], ob = yc + gate[bj][1] * acc[ai][bj][m][1];
                    own2line(oa, ob);
                    __builtin_nontemporal_store(oa, (f32x4*)(out + ro + col - 4 * fq));
                    __builtin_nontemporal_store(ob, (f32x4*)(out + ro + col - 4 * fq + 16)); }
                if (m & 1) asm volatile("" ::: "memory");
            }
    }
};

__device__ __forceinline__ int colmap_e(int np) {
    const int pn = np >> 8, c = np & 255, bj = c >> 7, wc = (c >> 5) & 3, w = c & 31;
    if (pn < 4) return (bj ? 1024 : 512) + pn * 128 + (c & 127);
    if (pn < 8) return (bj ? 1536 : 0) + (pn - 4) * 128 + (c & 127);
    const int fq = w >> 3, n = (w >> 2) & 1, i = w & 3, d = 32 * bj + 16 * n + 4 * fq + i;
    if (pn < 10) return 2048 + (4 * (pn - 8) + wc) * 64 + d;
    if (pn == 10) { if (wc < 2) return 2560 + wc * 64 + d; return 2688 + (wc - 2) * 64 + 32 * bj + w; }
    return 2816 + (pn - 11) * 256 + c;
}
__device__ __forceinline__ unsigned f2bf(float f) { unsigned u = __float_as_uint(f); return (u + 0x7fffu + ((u >> 16) & 1u)) >> 16; }
__device__ __forceinline__ unsigned pk2(float lo, float hi) { return f2bf(lo) | (f2bf(hi) << 16); }
template <bool PERME>
__device__ __forceinline__ void transpose_item(const float* W, int K, int N, bf16_t* WT, int row_off, LAS float* scr, int item, int lane) {
    const int nblk = N / 32, kb = item / nblk, nb = item % nblk, k0 = 64 * kb, n0 = 32 * nb;
    const int srcc = PERME ? colmap_e(n0 + (lane & 31)) : n0 + (lane & 31);
#pragma unroll 8
    for (int i = 0; i < 32; ++i) { const int kk = 2 * i + (lane >> 5); scr[kk * 33 + (lane & 31)] = __builtin_nontemporal_load(W + (size_t)(k0 + kk) * N + srcc); }
    asm volatile("s_waitcnt lgkmcnt(0)" ::: "memory");
    const int c = lane & 7;
#pragma unroll
    for (int j = 0; j < 4; ++j) { const int n = (lane >> 3) + 8 * j; const LAS float* s = scr + (8 * c) * 33 + n;
        u32x4 o; o.x = pk2(s[0 * 33], s[1 * 33]); o.y = pk2(s[2 * 33], s[3 * 33]); o.z = pk2(s[4 * 33], s[5 * 33]); o.w = pk2(s[6 * 33], s[7 * 33]);
        *(u32x4*)(WT + (size_t)(row_off + n0 + n) * K + k0 + 8 * c) = o; }
    asm volatile("s_waitcnt lgkmcnt(0)" ::: "memory");
}
__device__ __forceinline__ void gemv_block(LAS unsigned char* lds, const float* W, int N, int n0, const float* bias, float* out, int out_stride) {
    LAS float* s = (LAS float*)lds; LAS float* red = (LAS float*)(lds + 20480);
    const int tid = threadIdx.x, col = tid & 31, ks = tid >> 5;
    float a[5] = {0.f, 0.f, 0.f, 0.f, 0.f};
    const float* wp = W + (size_t)(ks * 64) * N + n0 + col;
#pragma unroll 16
    for (int k = 0; k < 64; ++k) { const float w = __builtin_nontemporal_load(wp + (size_t)k * N);
#pragma unroll
        for (int ci = 0; ci < 5; ++ci) a[ci] += s[ci * 1024 + ks * 64 + k] * w; }
#pragma unroll
    for (int ci = 0; ci < 5; ++ci) red[(ks * 5 + ci) * 32 + col] = a[ci];
    __syncthreads();
    if (tid < 160) { const int ci = tid >> 5; float t = bias ? bias[n0 + col] : 0.f;
#pragma unroll
        for (int k2 = 0; k2 < 16; ++k2) t += red[(k2 * 5 + ci) * 32 + col];
        out[ci * out_stride + n0 + col] = t; }
    __syncthreads();
}

struct AttnP { const bf16_t *Q, *K, *KC, *VtC, *VtL, *VCt, *SG; bf16_t* A2; const float* sink; };
constexpr int NH = 2;
#define MFMA16(a, b, c) __builtin_amdgcn_mfma_f32_16x16x32_bf16((a), (b), (c), 0, 0, 0)
__device__ __forceinline__ void attn_loadk(bf16x8 (&kf)[2][2], const bf16_t* kb, int k0, int Lk, int c16, int kq) {
#pragma unroll
    for (int kt = 0; kt < 2; ++kt) { int key = k0 + 8 * (c16 >> 2) + 4 * kt + (c16 & 3); key = key < 0 ? 0 : (key > Lk - 1 ? Lk - 1 : key);
#pragma unroll
        for (int ks = 0; ks < 2; ++ks) kf[kt][ks] = *(const bf16x8*)(kb + (size_t)key * 128 + 32 * ks + 8 * kq); }
}
__device__ __forceinline__ void attn_loadv(bf16x8 (&vf)[4], const bf16_t* vb, int k0, int Lk, int c16, int kq) {
    int tok = k0 + 8 * kq; tok = tok < 0 ? 0 : (tok > Lk - 8 ? Lk - 8 : tok);
#pragma unroll
    for (int dt = 0; dt < 4; ++dt) vf[dt] = *(const bf16x8*)(vb + (size_t)(tok >> 4) * 1024 + (16 * dt + c16) * 16 + (tok & 15));
}

__device__ __forceinline__ void rowpair(unsigned& m0, unsigned& m1) {
    u32x2p r = __builtin_amdgcn_permlane32_swap(m0, m1, false, false); m0 = r.x; m1 = r.y;
    r = __builtin_amdgcn_permlane16_swap(m0, m1, false, false); m0 = r.x; m1 = r.y;
}
__device__ __forceinline__ void attn_mask(f32x4& s0, f32x4& s1, int mode, int k0, int Lk, int tq, int kq) {
#pragma unroll
    for (int j = 0; j < 4; ++j) { const int ka = k0 + 8 * kq + j, kb2 = ka + 4; const int da = tq - ka, db = tq - kb2;
        const bool va = mode == 1 && ka >= 0 && ka < Lk && da <= 128 && da >= -128, vb2 = mode == 1 && kb2 >= 0 && kb2 < Lk && db <= 128 && db >= -128;
        s0[j] = va ? s0[j] : -1e30f; s1[j] = vb2 ? s1[j] : -1e30f; }
}
__device__ __forceinline__ void attn_compute(f32x4 (&o)[NH][4], float (&m2)[NH], float (&l)[NH], const bf16x8 (&qf)[NH][2],
                                             const bf16x8 (&kfA)[2][2], const bf16x8 (&vfA)[4], const bf16x8 (&kfB)[2][2], const bf16x8 (&vfB)[4],
                                             int modeA, int k0A, int LkA, int modeB, int k0B, int LkB, int tq, int kq) {
    f32x4 sa0[NH], sa1[NH], sb0[NH], sb1[NH];
#pragma unroll
    for (int hq = 0; hq < NH; ++hq) {
        const f32x4 z = {0.f, 0.f, 0.f, 0.f};
        sa0[hq] = MFMA16(kfA[0][0], qf[hq][0], z); sa1[hq] = MFMA16(kfA[1][0], qf[hq][0], z); sb0[hq] = MFMA16(kfB[0][0], qf[hq][0], z); sb1[hq] = MFMA16(kfB[1][0], qf[hq][0], z);
        sa0[hq] = MFMA16(kfA[0][1], qf[hq][1], sa0[hq]); sa1[hq] = MFMA16(kfA[1][1], qf[hq][1], sa1[hq]); sb0[hq] = MFMA16(kfB[0][1], qf[hq][1], sb0[hq]); sb1[hq] = MFMA16(kfB[1][1], qf[hq][1], sb1[hq]);
    }
    __builtin_amdgcn_sched_barrier(0);
#pragma unroll
    for (int hq = 0; hq < NH; ++hq) {
        f32x4 a0 = sa0[hq], a1 = sa1[hq], b0 = sb0[hq], b1 = sb1[hq];
        if (modeA) attn_mask(a0, a1, modeA, k0A, LkA, tq, kq);
        if (modeB) attn_mask(b0, b1, modeB, k0B, LkB, tq, kq);
        float mx = fmaxf(fmaxf(fmaxf(fmaxf(a0[0], a0[1]), fmaxf(a0[2], a0[3])), fmaxf(fmaxf(a1[0], a1[1]), fmaxf(a1[2], a1[3]))),
                         fmaxf(fmaxf(fmaxf(b0[0], b0[1]), fmaxf(b0[2], b0[3])), fmaxf(fmaxf(b1[0], b1[1]), fmaxf(b1[2], b1[3]))));
        mx = rowmax4(mx);
        if (__builtin_amdgcn_ballot_w64(mx > m2[hq] + 8.0f) != 0ull) {
            const float mn = fmaxf(m2[hq], mx), alpha = __builtin_amdgcn_exp2f(m2[hq] - mn); m2[hq] = mn; l[hq] *= alpha;
#pragma unroll
            for (int dt = 0; dt < 4; ++dt) o[hq][dt] = o[hq][dt] * alpha;
        }
        const float mr = m2[hq];
        float ps = 0.f;
#pragma unroll
        for (int j = 0; j < 4; ++j) { a0[j] = __builtin_amdgcn_exp2f(a0[j] - mr); a1[j] = __builtin_amdgcn_exp2f(a1[j] - mr); b0[j] = __builtin_amdgcn_exp2f(b0[j] - mr); b1[j] = __builtin_amdgcn_exp2f(b1[j] - mr); }
        ps = ((a0[0] + a0[1]) + (a0[2] + a0[3])) + ((a1[0] + a1[1]) + (a1[2] + a1[3])) + (((b0[0] + b0[1]) + (b0[2] + b0[3])) + ((b1[0] + b1[1]) + (b1[2] + b1[3])));
        l[hq] += ps;
        u32x4 pa, pb; pa.x = cvt_pk_bf16(a0[0], a0[1]); pa.y = cvt_pk_bf16(a0[2], a0[3]); pa.z = cvt_pk_bf16(a1[0], a1[1]); pa.w = cvt_pk_bf16(a1[2], a1[3]);
        pb.x = cvt_pk_bf16(b0[0], b0[1]); pb.y = cvt_pk_bf16(b0[2], b0[3]); pb.z = cvt_pk_bf16(b1[0], b1[1]); pb.w = cvt_pk_bf16(b1[2], b1[3]);
        const bf16x8 pfa = __builtin_bit_cast(bf16x8, pa), pfb = __builtin_bit_cast(bf16x8, pb);
#pragma unroll
        for (int dt = 0; dt < 4; ++dt) { o[hq][dt] = MFMA16(vfA[dt], pfa, o[hq][dt]); o[hq][dt] = MFMA16(vfB[dt], pfb, o[hq][dt]); }
        __builtin_amdgcn_sched_barrier(0);
    }
}

__device__ __forceinline__ void attn_unit(LAS unsigned char* lds, const AttnP& P, bool latent, int b, int kvh, int hq0, int q0, int lane, int pflags = 0) {
    const int c16 = lane & 15, kq = lane >> 4;
    const int L = latent ? 2048 : 256;
    const int rowbase = latent ? MCTX + b * 2048 : b * 256;
    const int qrow = rowbase + q0 + c16, tq = q0 + c16;
    bf16x8 qf[NH][2];
#pragma unroll
    for (int hq = 0; hq < NH; ++hq)
#pragma unroll
        for (int ks = 0; ks < 2; ++ks) qf[hq][ks] = *(const bf16x8*)(P.Q + (size_t)qrow * 512 + (4 * kvh + hq0 + hq) * 64 + 32 * ks + 8 * kq);
    u32x2 sgv[NH][4];
#pragma unroll
    for (int hq = 0; hq < NH; ++hq)
#pragma unroll
        for (int dt = 0; dt < 4; ++dt) sgv[hq][dt] = *(const u32x2*)(P.SG + (size_t)qrow * 512 + (4 * kvh + hq0 + hq) * 64 + 16 * dt + 4 * kq);
    f32x4 o[NH][4]; float m2[NH], l[NH];
#pragma unroll
    for (int hq = 0; hq < NH; ++hq) { m2[hq] = P.sink[4 * kvh + hq0 + hq] * LOG2E; l[hq] = kq == 0 ? 1.f : 0.f;
#pragma unroll
        for (int dt = 0; dt < 4; ++dt) o[hq][dt] = (f32x4){0.f, 0.f, 0.f, 0.f}; }
    const bf16_t* Kl = P.K + (size_t)rowbase * 128 + kvh * 64;
    const bf16_t* Vl = latent ? P.VtL + (size_t)(b * 2 + kvh) * 64 * 2048 : P.VtC + (size_t)(b * 2 + kvh) * 64 * 256;
    const bf16_t* Kc = P.KC + (size_t)b * 256 * 128 + kvh * 64;
    const bf16_t* Vc = P.VCt + (size_t)(b * 2 + kvh) * 64 * 256;
    int kloc0, nloc, nh;
    if (latent) { int st_lo = (128 - q0) / 32; if (st_lo < 0 || q0 > 128) st_lo = 0; int st_hi = (2176 - q0 + 31) / 32; if (st_hi > 9) st_hi = 9;
        kloc0 = q0 - 128 + 32 * st_lo; nloc = st_hi - st_lo; nh = nloc + 8; }
    else { kloc0 = 0; nloc = 8; nh = 8; }
    const int nsteps = (nh + 1) >> 1;
#define HSRC(h, kb_, vb_, k0_, Lk_, md_) const int hh_##k0_ = (h) < nh ? (h) : nh - 1; const bool lc_##k0_ = hh_##k0_ < nloc; \
        const bf16_t* kb_ = lc_##k0_ ? Kl : Kc; const bf16_t* vb_ = lc_##k0_ ? Vl : Vc; const int k0_ = lc_##k0_ ? kloc0 + 32 * hh_##k0_ : 32 * (hh_##k0_ - nloc); const int Lk_ = lc_##k0_ ? L : 256; \
        const int md_ = (h) >= nh ? 2 : ((latent && lc_##k0_ && (k0_ < 0 || k0_ + 32 > L || k0_ < q0 - 112 || k0_ + 31 > q0 + 128)) ? 1 : 0)
    bf16x8 kfA[2][2], kfB[2][2], knA[2][2], knB[2][2];
    { HSRC(0, kbA_, vbA_, k0A_, LkA_, mdA_); HSRC(1, kbB_, vbB_, k0B_, LkB_, mdB_); (void)vbA_; (void)vbB_; (void)mdA_; (void)mdB_;
      attn_loadk(kfA, kbA_, k0A_, LkA_, c16, kq); attn_loadk(kfB, kbB_, k0B_, LkB_, c16, kq); }
    for (int st = 0; st < nsteps; ++st) {
        bf16x8 vfA[4], vfB[4];
        HSRC(2 * st, kbA, vbA, k0A, LkA, mdA); HSRC(2 * st + 1, kbB, vbB, k0B, LkB, mdB); (void)kbA; (void)kbB;
        attn_loadv(vfA, vbA, k0A, LkA, c16, kq); attn_loadv(vfB, vbB, k0B, LkB, c16, kq);
        { HSRC(2 * st + 2, kbC, vbC, k0C, LkC, mdC); HSRC(2 * st + 3, kbD, vbD, k0D, LkD, mdD); (void)vbC; (void)vbD; (void)mdC; (void)mdD;
          attn_loadk(knA, kbC, k0C, LkC, c16, kq); attn_loadk(knB, kbD, k0D, LkD, c16, kq); }
        __builtin_amdgcn_sched_barrier(0);
        attn_compute(o, m2, l, qf, kfA, vfA, kfB, vfB, mdA, k0A, LkA, mdB, k0B, LkB, tq, kq);
#pragma unroll
        for (int kt = 0; kt < 2; ++kt) { kfA[kt][0] = knA[kt][0]; kfA[kt][1] = knA[kt][1]; kfB[kt][0] = knB[kt][0]; kfB[kt][1] = knB[kt][1]; }
    }
#undef HSRC
#pragma unroll
    for (int hq = 0; hq < NH; ++hq) {
        const float lt = rowsum4(l[hq]);
        const float inv = 1.f / lt;
        unsigned wx[4], wy[4];
#pragma unroll
        for (int dt = 0; dt < 4; ++dt) {
            const u32x2 sg = sgv[hq][dt];
            const f32x4 v = o[hq][dt] * inv;
            wx[dt] = cvt_pk_bf16(v[0] * bf_lo(sg.x), v[1] * bf_hi(sg.x)); wy[dt] = cvt_pk_bf16(v[2] * bf_lo(sg.y), v[3] * bf_hi(sg.y));
        }
        rowpair(wx[0], wx[1]); rowpair(wy[0], wy[1]); rowpair(wx[2], wx[3]); rowpair(wy[2], wy[3]);
        bf16_t* dst = P.A2 + (size_t)qrow * DM + 512 + (4 * kvh + hq0 + hq) * 64 + 8 * kq;
        if (!(pflags & 8)) { *(u32x4*)dst = (u32x4){wx[0], wy[0], wx[1], wy[1]}; *(u32x4*)(dst + 32) = (u32x4){wx[2], wy[2], wx[3], wy[3]}; }
    }
}

__device__ __forceinline__ void load8(const bf16_t* p, float (&v)[8]) { const u32x4 w = *(const u32x4*)p; v[0] = bf_lo(w.x); v[1] = bf_hi(w.x); v[2] = bf_lo(w.y); v[3] = bf_hi(w.y); v[4] = bf_lo(w.z); v[5] = bf_hi(w.z); v[6] = bf_lo(w.w); v[7] = bf_hi(w.w); }
__device__ __forceinline__ void unpack8(const u32x4 w, float (&v)[8]) { v[0] = bf_lo(w.x); v[1] = bf_hi(w.x); v[2] = bf_lo(w.y); v[3] = bf_hi(w.y); v[4] = bf_lo(w.z); v[5] = bf_hi(w.z); v[6] = bf_lo(w.w); v[7] = bf_hi(w.w); }
__device__ __forceinline__ void store8(bf16_t* p, const float (&v)[8]) { u32x4 w; w.x = cvt_pk_bf16(v[0], v[1]); w.y = cvt_pk_bf16(v[2], v[3]); w.z = cvt_pk_bf16(v[4], v[5]); w.w = cvt_pk_bf16(v[6], v[7]); *(u32x4*)p = w; }
__device__ __forceinline__ void conv_item(const bf16_t* U0, const bf16_t* BGA, bf16_t* A2, const float* cw, const float* cb, int item, int lane) {
    const int c = 8 * lane, r0 = 4 * item;
    const int t0 = r0 < MCTX ? (r0 & 255) : ((r0 - MCTX) & 2047), L = r0 < MCTX ? 256 : 2048;
    u32x4 ur[6], gr[4];
#pragma unroll
    for (int i = 0; i < 6; ++i) { const int t = t0 - 1 + i; const int rr = r0 - 1 + i + (t < 0 ? 1 : 0) - (t >= L ? 1 : 0); ur[i] = *(const u32x4*)(U0 + (size_t)rr * 512 + c); if (t < 0 || t >= L) ur[i] = (u32x4){0u, 0u, 0u, 0u}; }
#pragma unroll
    for (int i = 0; i < 4; ++i) gr[i] = *(const u32x4*)(BGA + (size_t)(r0 + i) * 512 + c);
    float w0[8], w1[8], w2[8], bb[8];
#pragma unroll
    for (int i = 0; i < 8; ++i) { w0[i] = cw[c + i]; w1[i] = cw[512 + c + i]; w2[i] = cw[1024 + c + i]; bb[i] = cb[c + i]; }
#pragma unroll
    for (int i = 0; i < 4; ++i) {
        float pv[8], cu[8], nx[8], g[8], y[8];
        unpack8(ur[i], pv); unpack8(ur[i + 1], cu); unpack8(ur[i + 2], nx); unpack8(gr[i], g);
#pragma unroll
        for (int k = 0; k < 8; ++k) y[k] = g[k] * (w0[k] * pv[k] + w1[k] * cu[k] + w2[k] * nx[k] + bb[k]);
        store8(A2 + (size_t)(r0 + i) * DM + c, y);
    }
}

template <int H>
__device__ __forceinline__ void pool_item_t(const bf16_t* U1, bf16_t* PO, int gi, int chunk, int lane) {
    constexpr int R = 4, NR = R - 1 + 2 * H;
    const int hw = lane >> 5, c = gi * 256 + 8 * (lane & 31), r0 = chunk * (2 * R) + R * hw;
    const int rs = r0 < MCTX ? (r0 & ~255) : MCTX + ((r0 - MCTX) & ~2047), L = r0 < MCTX ? 256 : 2048, t0 = r0 - rs;
    const bf16_t* base = U1 + (size_t)rs * DM + c;
    u32x4 raw[NR];
#pragma unroll
    for (int i = 0; i < NR; ++i) { const int t = t0 - H + i; const int tc = t < 0 ? 0 : (t > L - 1 ? L - 1 : t); raw[i] = *(const u32x4*)(base + (size_t)tc * DM); if (t < 0 || t >= L) raw[i] = (u32x4){0u, 0u, 0u, 0u}; }
    float S[8];
#pragma unroll
    for (int k = 0; k < 8; ++k) S[k] = 0.f;
#pragma unroll
    for (int i = 0; i < 2 * H; ++i) { float v[8]; unpack8(raw[i], v);
#pragma unroll
        for (int k = 0; k < 8; ++k) S[k] += v[k]; }
#pragma unroll
    for (int tt = 0; tt < R; ++tt) {
        const int t = t0 + tt, lo = t - H > 0 ? t - H : 0, hi = t + H < L ? t + H : L;
        const float rc = 1.f / (float)(hi - lo);
        float uc[8], y[8]; unpack8(raw[tt + H], uc);
#pragma unroll
        for (int k = 0; k < 8; ++k) y[k] = S[k] * rc - uc[k];
        store8(PO + (size_t)(rs + t) * DM + c, y);
        if (tt < R - 1) { float va[8], vs[8]; unpack8(raw[tt + 2 * H], va); unpack8(raw[tt], vs);
#pragma unroll
            for (int k = 0; k < 8; ++k) S[k] += va[k] - vs[k]; }
    }
}
__device__ __forceinline__ void pool_item(const bf16_t* U1, bf16_t* PO, int item, int lane, bool direct = false) {
    const int chunk = item >> 2, gi = direct ? (item & 3) : ((item + (item >> 11)) & 3);
    if (gi == 0) pool_item_t<1>(U1, PO, 0, chunk, lane);
    else if (gi == 1) pool_item_t<2>(U1, PO, 1, chunk, lane);
    else if (gi == 2) pool_item_t<4>(U1, PO, 2, chunk, lane);
    else pool_item_t<8>(U1, PO, 3, chunk, lane);
}


#define XB_TMO      128
#define XB_XCNT(j)  (256  + 64 * (j))
#define XB_XSUB(j)  (1280 + 64 * (j))
#define XB_XGEN(j)  (2304 + 64 * (j))
#define XB_TOP      3328
#define XB_TOPGEN   3392
#define XCD_BAR_WORDS 3456
#define XB_SPIN_CAP (1u << 18)
__device__ __forceinline__ unsigned xb_ld(unsigned* p)              { return __hip_atomic_load(p, __ATOMIC_RELAXED, __HIP_MEMORY_SCOPE_AGENT); }
__device__ __forceinline__ unsigned xb_add(unsigned* p, unsigned v) { return __hip_atomic_fetch_add(p, v, __ATOMIC_RELAXED, __HIP_MEMORY_SCOPE_AGENT); }
__device__ __forceinline__ unsigned xb_xcc_id() { return (unsigned)__builtin_amdgcn_s_getreg((3 << 11) | 20) & 0xFu; }
#define XB_SPIN(cond, bar) do { unsigned _sp = 0; while (cond) { __builtin_amdgcn_s_sleep(1); \
    if ((++_sp & 255u) == 0u) { if (xb_ld(&(bar)[XB_TMO])) break; if (_sp > XB_SPIN_CAP) { atomicAdd(&(bar)[XB_TMO], 1u); break; } } } } while (0)
struct XcdBarrier { unsigned* bar; unsigned x; volatile LAS unsigned* st; };
__device__ __forceinline__ XcdBarrier xcd_barrier_post(unsigned* bar, volatile LAS unsigned* st) {
    XcdBarrier b; b.bar = bar; b.x = xb_xcc_id(); b.st = st;
    if (threadIdx.x == 0) (void)xb_add(&bar[XB_XCNT(b.x)], 1u);
    return b;
}
__device__ __forceinline__ void xcd_barrier_complete(unsigned* bar, unsigned x, unsigned& nloc, unsigned& nx) {
    const unsigned G = gridDim.x * gridDim.y * gridDim.z;
    unsigned sum, cnt, mine, sp = 0u;
    for (;;) {
        sum = 0u; cnt = 0u; mine = 0u;
#pragma unroll
        for (unsigned j = 0; j < 16; ++j) { const unsigned c = xb_ld(&bar[XB_XCNT(j)]); sum += c; cnt += (c > 0u) ? 1u : 0u; mine = (j == x) ? c : mine; }
        if (sum == G) break;
        __builtin_amdgcn_s_sleep(1);
        if ((++sp & 255u) == 0u) { if (xb_ld(&bar[XB_TMO])) break; if (sp > XB_SPIN_CAP) { atomicAdd(&bar[XB_TMO], 1u); break; } }
    }
    nloc = mine > 0u ? mine : 1u; nx = cnt > 0u ? cnt : 1u;
}
__device__ __forceinline__ void xcd_barrier(const XcdBarrier& b) {
    asm volatile("s_waitcnt vmcnt(0)" ::: "memory");
    __syncthreads();
    if (threadIdx.x == 0) {
        unsigned* bar = b.bar;
        __builtin_amdgcn_s_waitcnt(0);
        unsigned nloc = b.st[0], nx = b.st[1];
        if (nloc == 0u) { xcd_barrier_complete(bar, b.x, nloc, nx); b.st[0] = nloc; b.st[1] = nx; }
        const unsigned old = xb_add(&bar[XB_XSUB(b.x)], 1u);
        const unsigned gen = old / nloc;
        if (old + 1u == (gen + 1u) * nloc) {
            __builtin_amdgcn_fence(__ATOMIC_RELEASE, "agent");
            asm volatile("s_waitcnt vmcnt(0)" ::: "memory");
            const unsigned og = xb_add(&bar[XB_TOP], 1u);
            const unsigned tg = og / nx;
            if (og + 1u == (tg + 1u) * nx) xb_add(&bar[XB_TOPGEN], 1u);
            else XB_SPIN(xb_ld(&bar[XB_TOPGEN]) == tg, bar);
            __builtin_amdgcn_fence(__ATOMIC_ACQUIRE, "agent");
            xb_add(&bar[XB_XGEN(b.x)], 1u);
            asm volatile("s_waitcnt vmcnt(0)" ::: "memory");
        } else {
            XB_SPIN(xb_ld(&bar[XB_XGEN(b.x)]) == gen, bar);
            __builtin_amdgcn_fence(__ATOMIC_ACQUIRE, "agent");
            asm volatile("s_waitcnt vmcnt(0)" ::: "memory");
        }
    }
    __syncthreads();
}

struct Args { const float* in[23]; float* out; unsigned char* ws; int ph_lo, ph_hi, coop, pad; };
enum { I_XP = 0, I_XS, I_CK, I_CV, I_C, I_CCTX, I_ADAWE, I_ADABE, I_NGE, I_WINE, I_CONVW, I_CONVB, I_QG, I_KG, I_SINK, I_WOUTE, I_ADAWO, I_ADABO, I_NGO, I_WINO, I_POOLW, I_PSCALE, I_WOUTO };

typedef const __attribute__((address_space(4))) Args* KArgs;
__device__ __forceinline__ KArgs opaque_args(KArgs p) { asm volatile("" : "+s"(p)); return p; }
#define WSP(T, off) ((T*)(A->ws + (off)))

__global__ void __launch_bounds__(512) mk_fwd(Args a_) {
    extern __shared__ __attribute__((aligned(16))) unsigned char lds_raw[];
    LAS unsigned char* lds = (LAS unsigned char*)lds_raw;
    cg::grid_group grid = cg::this_grid();
    KArgs ap = (KArgs)__builtin_amdgcn_kernarg_segment_ptr();
    const int G = gridDim.x, bx = blockIdx.x;
    const int lo = ap->ph_lo, hi = ap->ph_hi;
#define TIDS const int tid = threadIdx.x, lane = tid & 63, wave = __builtin_amdgcn_readfirstlane(tid >> 6); (void)lane; (void)wave
#ifndef PHM
#define PHM 0x1ff
#endif
#define IN(k) (((PHM >> (k)) & 1) && lo <= (k) && (k) < hi)
    volatile LAS unsigned* bst = (volatile LAS unsigned*)(lds + 131072);
    if (threadIdx.x < 4) bst[threadIdx.x] = 0u;
    __syncthreads();
    XcdBarrier xbar; xbar.bar = (unsigned*)(ap->ws + WS_BAR); xbar.x = 0; xbar.st = bst;
    if (ap->coop == 1) xbar = xcd_barrier_post((unsigned*)(ap->ws + WS_BAR), bst);
    if (ap->coop == 2) grid.sync();
#define SEAM(k) do { if (IN(k) && IN((k) + 1)) xcd_barrier(xbar); } while (0)

    for (int rep_ = 0, nrep_ = (PROBE_PH == 0 ? 1 + ap->pad : 1); rep_ < nrep_; ++rep_) { if (rep_) xcd_barrier(xbar);
    if (IN(0)) {
        KArgs A = opaque_args(ap); TIDS;
        float* ADA = WSP(float, WS_ADA); float* ROPE = WSP(float, WS_ROPE); float* ROWSS = WSP(float, WS_ROWSS); bf16_t* KC = WSP(bf16_t, WS_KC); bf16_t* VCT = WSP(bf16_t, WS_VCT);
        bf16_t* WE = WSP(bf16_t, WS_WE); bf16_t* WOE = WSP(bf16_t, WS_WOE); bf16_t* WIO = WSP(bf16_t, WS_WIO); bf16_t* PW = WSP(bf16_t, WS_PW); bf16_t* WOO = WSP(bf16_t, WS_WOO);

        const int gt = bx * 512 + tid, NT = G * 512;
        for (int i = gt; i < MROWS; i += NT) ROWSS[i] = 0.f;
        for (int i = gt; i < 131072; i += NT) {
            { const int p = i & 63, bj = p >> 5, w = p & 31, fq = w >> 3, n = (w >> 2) & 1, ii = w & 3, d = 32 * bj + 16 * n + 4 * fq + ii;
              KC[i] = (bf16_t)f2bf(A->in[I_CK][(i & ~63) + d]); }
            { const int t = i & 255, d = (i >> 8) & 63, hv = (i >> 14) & 1, b = i >> 15;
              VCT[(b * 2 + hv) * 16384 + (t >> 4) * 1024 + d * 16 + (t & 15)] = (bf16_t)f2bf(A->in[I_CV][((size_t)(b * 256 + t) * 2 + hv) * 64 + d]); }
        }
        if (bx == G - 1) {
            for (int i = tid; i < 1024; i += 512) { const int pos = i >> 4, f = i & 15;
                const float inv = __builtin_amdgcn_exp2f(-(float)f * (13.287712379549449f / 16.f)); const float ang = (float)pos * inv;
                const float rev = ang * 0.15915494309189535f; const float fr_ = rev - rintf(rev);
                ROPE[i] = __builtin_amdgcn_cosf(fr_); ROPE[1024 + i] = __builtin_amdgcn_sinf(fr_); }
        }
        for (int it = bx; it < 192; it += G) {
            const int l = it / 96, n0 = (it % 96) * 32;
            LAS float* s = (LAS float*)lds;
            for (int i = tid; i < 5120; i += 512) { const int ci = i >> 10, k = i & 1023; const float x = ci == 0 ? A->in[I_CCTX][k] : A->in[I_C][(ci - 1) * 1024 + k]; s[i] = silu_f(x); }
            __syncthreads();
            gemv_block(lds, l == 0 ? A->in[I_ADAWE] : A->in[I_ADAWO], 3072, n0, l == 0 ? A->in[I_ADABE] : A->in[I_ADABO], ADA + l * 15360, 3072);
        }
        {
            LAS float* scr = (LAS float*)(lds + wave * 16384);
            const int gw = bx * 8 + wave, NGW = G * 8;
            constexpr int I_E = 16 * (NE / 32);
            const bool late = (G == 256);
            constexpr int I_OE = 16 * 32, I_IO = 16 * (NO / 32), I_P = 4 * 32, I_OO = 16 * 32, NIT = I_E + I_OE + I_IO + I_P + I_OO;
            for (int it = gw; it < (late ? I_E : NIT); it += NGW) {
                int r = it;
                if (r < I_E) { transpose_item<true>(A->in[I_WINE], 1024, NE, WE, 0, scr, r, lane); continue; } r -= I_E;
                if (r < I_OE) { transpose_item<false>(A->in[I_WOUTE], 1024, 1024, WOE, 0, scr, r, lane); continue; } r -= I_OE;
                if (r < I_IO) { transpose_item<false>(A->in[I_WINO], 1024, NO, WIO, 0, scr, r, lane); continue; } r -= I_IO;
                if (r < I_P) { const int g4 = r >> 5; transpose_item<false>(A->in[I_POOLW] + (size_t)g4 * 65536, 256, 256, PW, g4 * 256, scr, r & 31, lane); continue; } r -= I_P;
                transpose_item<false>(A->in[I_WOUTO], 1024, 1024, WOO, 0, scr, r, lane);
            }
        }
        __syncthreads();
    }
    }
    SEAM(0);
    for (int rep_ = 0, nrep_ = (PROBE_PH == 1 ? 1 + ap->pad : 1); rep_ < nrep_; ++rep_) { if (rep_) xcd_barrier(xbar);
    if (IN(1)) {
        KArgs A = opaque_args(ap); TIDS;
        float* ADA = WSP(float, WS_ADA); float* SB = WSP(float, WS_SB); bf16_t* H0 = WSP(bf16_t, WS_H0);

        for (int it = bx; it < (G == 256 ? 0 : 64); it += G) {
            LAS float* s = (LAS float*)lds;
            for (int i = tid; i < 5120; i += 512) { const int ci = i >> 10, k = i & 1023; s[i] = ADA[15360 + ci * 3072 + k]; }
            __syncthreads();
            gemv_block(lds, A->in[I_WINO], NO, it * 32, nullptr, SB, NO);
        }
        const int gw = bx * 8 + wave, NGW = G * 8;
        for (int r = gw; r < MROWS; r += 2 * NGW) {
            const int r2 = r + NGW < MROWS ? r + NGW : r;
            const float* xa = r < MCTX ? A->in[I_XP] + (size_t)r * DM : A->in[I_XS] + (size_t)(r - MCTX) * DM;
            const float* xb = r2 < MCTX ? A->in[I_XP] + (size_t)r2 * DM : A->in[I_XS] + (size_t)(r2 - MCTX) * DM;
            f32x4 va[4], vb[4]; float sa = 0.f, sb2 = 0.f;
#pragma unroll
            for (int j = 0; j < 4; ++j) { va[j] = __builtin_nontemporal_load((const f32x4*)(xa + 4 * lane + 256 * j)); vb[j] = __builtin_nontemporal_load((const f32x4*)(xb + 4 * lane + 256 * j)); }
#pragma unroll
            for (int j = 0; j < 4; ++j) { sa += (va[j][0] * va[j][0] + va[j][1] * va[j][1]) + (va[j][2] * va[j][2] + va[j][3] * va[j][3]);
                                          sb2 += (vb[j][0] * vb[j][0] + vb[j][1] * vb[j][1]) + (vb[j][2] * vb[j][2] + vb[j][3] * vb[j][3]); }
#pragma unroll
            for (int o = 1; o < 64; o <<= 1) { sa += __shfl_xor(sa, o); sb2 += __shfl_xor(sb2, o); }
            const float rsa = __builtin_amdgcn_rsqf(sa * (1.f / 1024.f) + EPSN), rsb = __builtin_amdgcn_rsqf(sb2 * (1.f / 1024.f) + EPSN);
            const int cia = cond_of_row(r), cib = cond_of_row(r2);
#pragma unroll
            for (int j = 0; j < 4; ++j) { const int k = 4 * lane + 256 * j;
                const f32x4 g = *(const f32x4*)(A->in[I_NGE] + k);
                { const f32x4 sh = *(const f32x4*)(ADA + cia * 3072 + k), sc = *(const f32x4*)(ADA + cia * 3072 + 1024 + k);
                  const f32x4 h = va[j] * rsa * g * (sc + 1.0f) + sh; u32x2 w; w.x = cvt_pk_bf16(h[0], h[1]); w.y = cvt_pk_bf16(h[2], h[3]);
                  *(u32x2*)(H0 + (size_t)r * DM + k) = w; }
                { const f32x4 sh = *(const f32x4*)(ADA + cib * 3072 + k), sc = *(const f32x4*)(ADA + cib * 3072 + 1024 + k);
                  const f32x4 h = vb[j] * rsb * g * (sc + 1.0f) + sh; u32x2 w; w.x = cvt_pk_bf16(h[0], h[1]); w.y = cvt_pk_bf16(h[2], h[3]);
                  *(u32x2*)(H0 + (size_t)r2 * DM + k) = w; }
            }
        }
    }
    }
    SEAM(1);
    for (int rep_ = 0, nrep_ = (PROBE_PH == 2 ? 1 + ap->pad : 1); rep_ < nrep_; ++rep_) { if (rep_) xcd_barrier(xbar);
    if (IN(2)) {
        KArgs A = opaque_args(ap); TIDS;
        float* outk = A->out + (size_t)MROWS * DM; float* outv = outk + 524288; float* ROPE = WSP(float, WS_ROPE);

        pg8::Gemm g{WSP(bf16_t, WS_H0), WSP(bf16_t, WS_WE), MROWS, NE, 1024, 1024, 1024, 0}; pg8::StaticOrder S; S.init(MROWS, NE, G, bx);
        EpiE E{WSP(bf16_t, WS_U0), WSP(bf16_t, WS_BGA), WSP(bf16_t, WS_Q), WSP(bf16_t, WS_K), WSP(bf16_t, WS_VT), WSP(bf16_t, WS_VT + 1 * MiB), WSP(bf16_t, WS_SG), outk, outv, A->in[I_QG], A->in[I_KG], ROPE, ROPE + 1024};
        pg8::gemm_phase<EpiE, true>(lds, g, S, E);
        if (G == 256 && bx >= 112) {
            bf16_t* WOE = WSP(bf16_t, WS_WOE); bf16_t* WIO = WSP(bf16_t, WS_WIO); bf16_t* PW = WSP(bf16_t, WS_PW); bf16_t* WOO = WSP(bf16_t, WS_WOO);
            LAS float* scr = (LAS float*)(lds + wave * 16384);
            constexpr int I_OE = 16 * 32, I_IO = 16 * (NO / 32), I_P = 4 * 32, I_OO = 16 * 32, NIT2 = I_OE + I_IO + I_P + I_OO;
            for (int it = (bx - 112) * 8 + wave; it < NIT2; it += 144 * 8) {
                int r = it;
                if (r < I_OE) { transpose_item<false>(A->in[I_WOUTE], 1024, 1024, WOE, 0, scr, r, lane); continue; } r -= I_OE;
                if (r < I_IO) { transpose_item<false>(A->in[I_WINO], 1024, NO, WIO, 0, scr, r, lane); continue; } r -= I_IO;
                if (r < I_P) { const int g4 = r >> 5; transpose_item<false>(A->in[I_POOLW] + (size_t)g4 * 65536, 256, 256, PW, g4 * 256, scr, r & 31, lane); continue; } r -= I_P;
                transpose_item<false>(A->in[I_WOUTO], 1024, 1024, WOO, 0, scr, r, lane);
            }
        }
    }
    }
    SEAM(2);
    for (int rep_ = 0, nrep_ = (PROBE_PH == 3 ? 1 + (ap->pad & 7) : 1); rep_ < nrep_; ++rep_) { if (rep_) xcd_barrier(xbar);
    if (IN(3)) {
        KArgs A = opaque_args(ap); TIDS;

        AttnP P{WSP(bf16_t, WS_Q), WSP(bf16_t, WS_K), WSP(bf16_t, WS_KC), WSP(bf16_t, WS_VT), WSP(bf16_t, WS_VT + 1 * MiB), WSP(bf16_t, WS_VCT), WSP(bf16_t, WS_SG), WSP(bf16_t, WS_A2), A->in[I_SINK]};
        const int vb = (G % 8 == 0) ? (bx % 8) * (G / 8) + bx / 8 : bx;
        const int part = (PROBE_PH == 3 && rep_) ? (ap->pad >> 8) & 7 : 7, pfl = (PROBE_PH == 3 && rep_) ? (ap->pad >> 8) & 24 : 0;
        if (part & 1) for (int u = vb * 8 + wave; u < 2048; u += G * 8) attn_unit(lds, P, true, u >> 9, (u >> 8) & 1, ((u >> 7) & 1) * 2, (u & 127) * 16, lane, pfl);
        if (wave < 4) { if (part & 2) for (int c = vb * 4 + wave; c < 1024; c += G * 4) attn_unit(lds, P, false, c >> 6, (c >> 5) & 1, ((c >> 4) & 1) * 2, (c & 15) * 16, lane, pfl); }
        else { if (part & 4) for (int it = vb * 4 + (wave - 4); it < 3072; it += G * 4) conv_item(WSP(bf16_t, WS_U0), WSP(bf16_t, WS_BGA), WSP(bf16_t, WS_A2), A->in[I_CONVW], A->in[I_CONVB], it, lane); }
    }
    }
    SEAM(3);
    if (IN(4)) {
        KArgs A = opaque_args(ap); TIDS;
        float* ADA = WSP(float, WS_ADA);

        pg8::Gemm g{WSP(bf16_t, WS_A2), WSP(bf16_t, WS_WOE), MROWS, 1024, 1024, 1024, 1024, 0}; pg8::StaticOrder S; S.init(MROWS, 1024, G, bx);
        EpiOut0 E{A->in[I_XP], A->in[I_XS], ADA, ADA + 15360, A->in[I_NGO], WSP(bf16_t, WS_Y1), WSP(bf16_t, WS_Y1G), WSP(float, WS_ROWSS)};
        pg8::gemm_phase<EpiOut0, true>(lds, g, S, E);
        if (G == 256 && bx >= 192) {
            float* SB = WSP(float, WS_SB);
            LAS float* s = (LAS float*)lds;
            for (int i = tid; i < 5120; i += 512) { const int ci = i >> 10, k = i & 1023; s[i] = ADA[15360 + ci * 3072 + k]; }
            __syncthreads();
            gemv_block(lds, A->in[I_WINO], NO, (bx - 192) * 32, nullptr, SB, NO);
        }
    }
    SEAM(4);
    for (int rep_ = 0, nrep_ = (PROBE_PH == 5 ? 1 + ap->pad : 1); rep_ < nrep_; ++rep_) { if (rep_) xcd_barrier(xbar);
    if (IN(5)) {
        KArgs A = opaque_args(ap); TIDS;

        pg8::Gemm g{WSP(bf16_t, WS_Y1G), WSP(bf16_t, WS_WIO), MROWS, NO, 1024, 1024, 1024, 0}; pg8::StaticOrder S; S.init(MROWS, NO, G, bx);
        EpiOdd E{WSP(float, WS_ROWSS), WSP(float, WS_SB), WSP(bf16_t, WS_U1), WSP(bf16_t, WS_SG2)};
        pg8::gemm_phase<EpiOdd, true>(lds, g, S, E);
    }
    }
    SEAM(5);
    for (int rep_ = 0, nrep_ = (PROBE_PH == 6 ? 1 + ap->pad : 1); rep_ < nrep_; ++rep_) { if (rep_) xcd_barrier(xbar);
    if (IN(6)) {
        KArgs A = opaque_args(ap); TIDS;

        if (G < 192) for (int it = bx * 8 + wave; it < 6144; it += G * 8) pool_item(WSP(bf16_t, WS_U1), WSP(bf16_t, WS_POOLED), it, lane);
    }
    }
    if (G < 192) SEAM(6);
    for (int rep_ = 0, nrep_ = (PROBE_PH == 7 ? 1 + ap->pad : 1); rep_ < nrep_; ++rep_) { if (rep_) xcd_barrier(xbar);
    if (IN(7)) {
        KArgs A = opaque_args(ap); TIDS;

        pg8::Gemm g{WSP(bf16_t, WS_POOLED), WSP(bf16_t, WS_PW), MROWS, 1024, 256, 1024, 256, 512}; pg8::StaticOrder S; S.init(MROWS, 1024, G, bx);
        if (G >= 192) {
            pg8::Unit u0;
            if (S.next(0, u0)) {
                for (int j = wave; j < 32; j += 8) pool_item(WSP(bf16_t, WS_U1), WSP(bf16_t, WS_POOLED), (u0.pm * 32 + j) * 4 + u0.pn, lane, true);
            }
            asm volatile("s_waitcnt vmcnt(0)" ::: "memory");
            __syncthreads();
        }
        EpiPool E{A->in[I_PSCALE], WSP(bf16_t, WS_SG2), WSP(bf16_t, WS_A4)};
        pg8::gemm_phase<EpiPool, true>(lds, g, S, E);
    }
    }
    SEAM(7);
    for (int rep_ = 0, nrep_ = (PROBE_PH == 8 ? 1 + ap->pad : 1); rep_ < nrep_; ++rep_) { if (rep_) xcd_barrier(xbar);
    if (IN(8)) {
        KArgs A = opaque_args(ap); TIDS;

        pg8::Gemm g{WSP(bf16_t, WS_A4), WSP(bf16_t, WS_WOO), MROWS, 1024, 1024, 1024, 1024, 0}; pg8::StaticOrder S; S.init(MROWS, 1024, G, bx);
        EpiFinal E{WSP(bf16_t, WS_Y1), WSP(float, WS_ADA) + 15360, A->out};
        pg8::gemm_phase<EpiFinal, true>(lds, g, S, E);
    }
    }
#ifdef PROBE_SYNC
    for (int q_ = 0; q_ < 8; ++q_) xcd_barrier(xbar);
#endif
#undef IN
#undef SEAM
}

extern "C" void kernel_launch(void* const* d_in, const int* in_sizes, int n_in, void* d_out, int out_size, void* d_ws, size_t ws_size, hipStream_t stream) {
    static int grid = 0;
    if (grid == 0) {
        int dev = 0, cus = 0, per_cu = 0;
        hipGetDevice(&dev);
        hipDeviceGetAttribute(&cus, hipDeviceAttributeMultiprocessorCount, dev);
        if (hipFuncSetAttribute((const void*)mk_fwd, hipFuncAttributeMaxDynamicSharedMemorySize, LDS_BYTES) != hipSuccess) fprintf(stderr, "kernel_launch: hipFuncSetAttribute failed\n");
        if (hipOccupancyMaxActiveBlocksPerMultiprocessor(&per_cu, (const void*)mk_fwd, 512, LDS_BYTES) != hipSuccess || per_cu < 1) { fprintf(stderr, "kernel_launch: occupancy query gave %d\n", per_cu); per_cu = 1; }
        (void)hipGetLastError();
        grid = cus * per_cu; if (grid > 256) grid = 256;
        if (n_in != 23 || ws_size < WS_END) { fprintf(stderr, "kernel_launch: unexpected n_in %d / ws %zu\n", n_in, ws_size); }
    }
    Args a{};
    for (int i = 0; i < 23; ++i) a.in[i] = (const float*)d_in[i];
    a.out = (float*)d_out; a.ws = (unsigned char*)d_ws;
#if MK_MULTI
    for (int ph = 0; ph < 9; ++ph) { a.ph_lo = ph; a.ph_hi = ph + 1; a.coop = 0; hipLaunchKernelGGL(mk_fwd, dim3(grid), dim3(512), LDS_BYTES, stream, a); }
#else
    for (int ph = 0; ph <= PROBE_PREFIX; ++ph) { a.ph_lo = ph; a.ph_hi = ph + 1; a.coop = 0; hipLaunchKernelGGL(mk_fwd, dim3(grid), dim3(512), LDS_BYTES, stream, a); }
    a.ph_lo = 0; a.ph_hi = 9; a.coop = 1; a.pad = PROBE_REPS;
    (void)hipMemsetAsync((char*)d_ws + WS_BAR, 0, 16384, stream);
    void* args[] = {&a};
    hipError_t e = hipLaunchCooperativeKernel((const void*)mk_fwd, dim3(grid), dim3(512), args, LDS_BYTES, stream);
    if (e != hipSuccess) fprintf(stderr, "cooperative launch failed: %s (grid %d)\n", hipGetErrorString(e), grid);
#endif
}
```

```cpp
#include <hip/hip_runtime.h>
#include <hip/hip_cooperative_groups.h>
#include <cstdio>
#include <cstdint>
namespace cg = cooperative_groups;

#ifndef MK_MULTI
#define MK_MULTI 0
#endif
#ifndef PROBE_REPS
#define PROBE_REPS 0
#endif
#ifndef PROBE_PH
#define PROBE_PH -1
#endif
#ifndef PROBE_PREFIX
#define PROBE_PREFIX -1
#endif

#define LAS __attribute__((address_space(3)))
typedef unsigned short bf16_t;
typedef short bf16x8 __attribute__((ext_vector_type(8)));
typedef float f32x4 __attribute__((ext_vector_type(4)));
typedef unsigned u32x4 __attribute__((ext_vector_type(4)));
typedef unsigned u32x2 __attribute__((ext_vector_type(2)));

constexpr int MROWS = 12288, MCTX = 4096, DM = 1024, NE = 3328, NO = 2048;
constexpr float EPSN = 1e-6f, LOG2E = 1.4426950408889634f;
constexpr size_t MiB = 1u << 20;
constexpr size_t WS_ADA = 0, WS_SB = 131072, WS_ROPE = 196608, WS_ROWSS = 262144, WS_BAR = 327680, WS_KC = 524288, WS_VCT = 786432;
constexpr size_t WS_WE = 1 * MiB, WS_WOE = 8 * MiB, WS_WIO = 10 * MiB, WS_PW = 14 * MiB, WS_WOO = 15 * MiB;
constexpr size_t WS_H0 = 18 * MiB, WS_U0 = 42 * MiB, WS_BGA = 54 * MiB, WS_Q = 66 * MiB, WS_K = 78 * MiB, WS_VT = 81 * MiB, WS_SG = 84 * MiB;
constexpr size_t WS_A2 = 96 * MiB, WS_Y1 = 120 * MiB, WS_END = 168 * MiB;
constexpr size_t WS_Y1G = WS_H0, WS_POOLED = WS_H0, WS_U1 = WS_A2, WS_SG2 = WS_U0, WS_A4 = WS_A2;
constexpr int LDS_BYTES = 131072 + 1024;

__device__ __forceinline__ unsigned cvt_pk_bf16(float lo, float hi) { unsigned r; asm volatile("v_cvt_pk_bf16_f32 %0, %1, %2" : "=v"(r) : "v"(lo), "v"(hi)); return r; }
__device__ __forceinline__ float bf_lo(unsigned w) { return __uint_as_float(w << 16); }
__device__ __forceinline__ float bf_hi(unsigned w) { return __uint_as_float(w & 0xffff0000u); }
__device__ __forceinline__ float silu_f(float x) { return x * __builtin_amdgcn_rcpf(1.f + __expf(-x)); }
typedef unsigned u32x2p __attribute__((ext_vector_type(2)));
__device__ __forceinline__ float rowmax4(float x) {
    unsigned xi = __float_as_uint(x); u32x2p r = __builtin_amdgcn_permlane32_swap(xi, xi, false, false);
    const float m = fmaxf(__uint_as_float(r.x), __uint_as_float(r.y)); xi = __float_as_uint(m);
    r = __builtin_amdgcn_permlane16_swap(xi, xi, false, false); return fmaxf(__uint_as_float(r.x), __uint_as_float(r.y));
}
__device__ __forceinline__ float rowsum4(float x) {
    unsigned xi = __float_as_uint(x); u32x2p r = __builtin_amdgcn_permlane32_swap(xi, xi, false, false);
    const float m = __uint_as_float(r.x) + __uint_as_float(r.y); xi = __float_as_uint(m);
    r = __builtin_amdgcn_permlane16_swap(xi, xi, false, false); return __uint_as_float(r.x) + __uint_as_float(r.y);
}
__device__ __forceinline__ void own2line(f32x4& a, f32x4& b) {
#pragma unroll
    for (int i = 0; i < 4; ++i) { unsigned x = __float_as_uint(a[i]), y = __float_as_uint(b[i]);
        u32x2p r = __builtin_amdgcn_permlane16_swap(x, y, false, false); r = __builtin_amdgcn_permlane32_swap(r.x, r.y, false, false);
        a[i] = __uint_as_float(r.x); b[i] = __uint_as_float(r.y); }
}
__device__ __forceinline__ void line2own(f32x4& a, f32x4& b) {
#pragma unroll
    for (int i = 0; i < 4; ++i) { unsigned x = __float_as_uint(a[i]), y = __float_as_uint(b[i]);
        u32x2p r = __builtin_amdgcn_permlane32_swap(x, y, false, false); r = __builtin_amdgcn_permlane16_swap(r.x, r.y, false, false);
        a[i] = __uint_as_float(r.x); b[i] = __uint_as_float(r.y); }
}
__device__ __forceinline__ int cond_of_row(int r) { return r < MCTX ? 0 : 1 + ((r - MCTX) >> 11); }

namespace pg8 {
constexpr int BM = 256, BK = 64, HALF = 128, HTB = HALF * BK * 2, STAGE_BYTES = 8 * HTB, NXCD = 8, WGM = 8;
__device__ __forceinline__ int lds_byte(int r, int c) { const int st = (r >> 4) * 2 + (c >> 5), rr = r & 15, cc = c & 31, ob = rr * 64 + cc * 2; return st * 1024 + (ob ^ (((ob >> 9) & 1) << 5)); }
__device__ __forceinline__ void stage_rc(int b, int& R, int& C) { const int st = b / 1024, sb = b % 1024, swz = sb ^ (((sb >> 9) & 1) << 5); R = (st >> 1) * 16 + swz / 64; C = (st & 1) * 32 + (swz % 64) / 2; }
__device__ __forceinline__ int perm32(int rho) { const int n = rho >> 4, i = rho & 15; return 8 * (i >> 2) + 4 * n + (i & 3); }
struct Unit { int pm, pn; };
struct Gemm { const bf16_t* A; const bf16_t* Bt; int M, N, K, lda, ldb, a_pn_off; };
struct StaticOrder {
    int nM, nN, nwg, G, c;
    __device__ void init(int M, int N, int G_, int c_) { nM = M / BM; nN = N / BM; nwg = nM * nN; G = G_; c = c_; }
    __device__ bool next(int i, Unit& u) const {
        const long L = (long)i * G + c; if (L >= nwg) return false;
        int wgid = (int)L; { const int q = nwg / NXCD, r = nwg % NXCD, xcd = wgid % NXCD, off = wgid / NXCD; wgid = (xcd < r ? xcd * (q + 1) : r * (q + 1) + (xcd - r) * q) + off; }
        const int nig = WGM * nN, gid = wgid / nig, fm = gid * WGM, gsz = (nM - fm) < WGM ? (nM - fm) : WGM;
        u.pm = fm + ((wgid % nig) % gsz); u.pn = (wgid % nig) / gsz; return true;
    }
};
template <class Epi, bool ALIGN_EPI>
__device__ __forceinline__ void gemm_phase(LAS unsigned char* lds, const Gemm g, const StaticOrder& S, const Epi& E) {
    const int tid = threadIdx.x, wid = __builtin_amdgcn_readfirstlane(tid >> 6), lane = tid & 63, wr = wid >> 2, wc = wid & 3, fr = lane & 15, fq = lane >> 4;
    const int K = g.K, nt = K / BK;
    unsigned voffA[2], voffB[2];
#pragma unroll
    for (int i = 0; i < 2; ++i) { int R, C; stage_rc(tid * 16 + i * 8192, R, C); const int Rb = Epi::PERM ? ((R & ~31) + perm32(R & 31)) : R;
        voffA[i] = (unsigned)(R * g.lda + C) * 2u; voffB[i] = (unsigned)(Rb * g.ldb + C) * 2u; }
    const size_t kstep = (size_t)(BK * 2);
    const size_t hstepA = (size_t)HALF * g.lda * 2, hstepB = (size_t)HALF * g.ldb * 2;
    const size_t tstepA = 2 * hstepA, tstepB = 2 * hstepB;
    const unsigned ldsw = (unsigned)wid * 1024u;
    const int aoff = lds_byte(wr * 64 + fr, fq * 8), boff = lds_byte(wc * 32 + fr, fq * 8);
#define PG8_SA(b, h) (((b) * 2 + (h)) * HTB)
#define PG8_SB(b, h) ((4 + (b) * 2 + (h)) * HTB)
#define PG8_STAGE(bufoff, gbase, voff) do { _Pragma("unroll") for (int _i = 0; _i < 2; ++_i) \
        __builtin_amdgcn_global_load_lds((const unsigned*)((const char*)(gbase) + (voff)[_i]), (LAS unsigned*)(lds + (bufoff) + ldsw + _i * 8192), 16, 0, 0); } while (0)
#define PG8_LDA(dst, b, h) do { _Pragma("unroll") for (int m = 0; m < 4; ++m) _Pragma("unroll") for (int k = 0; k < 2; ++k) dst[m][k] = *(const LAS bf16x8*)(lds + PG8_SA(b, h) + aoff + m * 2048 + k * 1024); } while (0)
#define PG8_LDB(dst, b, h) do { _Pragma("unroll") for (int n = 0; n < 2; ++n) _Pragma("unroll") for (int k = 0; k < 2; ++k) dst[n][k] = *(const LAS bf16x8*)(lds + PG8_SB(b, h) + boff + n * 2048 + k * 1024); } while (0)
#define PG8_MMA(ai, bj, At, Bt) do { __builtin_amdgcn_s_setprio(1); _Pragma("unroll") for (int m = 0; m < 4; ++m) _Pragma("unroll") for (int n = 0; n < 2; ++n) _Pragma("unroll") for (int k = 0; k < 2; ++k) \
        acc[ai][bj][m][n] = __builtin_amdgcn_mfma_f32_16x16x32_bf16(Bt[n][k], At[m][k], acc[ai][bj][m][n], 0, 0, 0); __builtin_amdgcn_s_setprio(0); } while (0)
#define PG8_WAIT_V(n) asm volatile("s_waitcnt vmcnt(" #n ")" ::: "memory")
#define PG8_WAIT_L(n) asm volatile("s_waitcnt lgkmcnt(" #n ")" ::: "memory")
#define PG8_BAR __builtin_amdgcn_s_barrier()
#define PG8_SCHED __builtin_amdgcn_sched_barrier(0)
    Unit cur, nxt; int ui = 0;
    if (!S.next(0, cur)) return;
    f32x4 acc[2][2][4][2];
#pragma unroll
    for (int a = 0; a < 2; ++a)
#pragma unroll
        for (int b = 0; b < 2; ++b)
#pragma unroll
            for (int m = 0; m < 4; ++m)
#pragma unroll
                for (int n = 0; n < 2; ++n) acc[a][b][m][n] = (f32x4){0.f, 0.f, 0.f, 0.f};
    bf16x8 At[4][2], B0[2][2], B1[2][2];
    const char* cA = (const char*)g.A + (size_t)cur.pm * tstepA + (size_t)cur.pn * g.a_pn_off; const char* cB = (const char*)g.Bt + (size_t)cur.pn * tstepB;
    PG8_STAGE(PG8_SB(0, 0), cB, voffB); PG8_STAGE(PG8_SB(0, 1), cB + hstepB, voffB); PG8_STAGE(PG8_SA(0, 0), cA, voffA); PG8_STAGE(PG8_SA(0, 1), cA + hstepA, voffA);
    if (wr == 1) PG8_BAR;
    PG8_WAIT_V(2); PG8_BAR;
    PG8_STAGE(PG8_SB(1, 0), cB + kstep, voffB); PG8_STAGE(PG8_SA(1, 0), cA + kstep, voffA); PG8_STAGE(PG8_SB(1, 1), cB + hstepB + kstep, voffB);
    PG8_WAIT_V(6); PG8_BAR;
    for (;;) {
        const bool has_next = S.next(ui + 1, nxt);
        const char* nA = has_next ? (const char*)g.A + (size_t)nxt.pm * tstepA + (size_t)nxt.pn * g.a_pn_off : cA; const char* nB = has_next ? (const char*)g.Bt + (size_t)nxt.pn * tstepB : cB;
#pragma nounroll
        for (int t = 0; t < nt; t += 2) {
            const bool last = (t == nt - 2);
            const char* a1 = cA + (size_t)(t + 1) * kstep;
            const char* a2 = last ? nA : cA + (size_t)(t + 2) * kstep; const char* b2 = last ? nB : cB + (size_t)(t + 2) * kstep;
            const char* a3 = a2 + kstep; const char* b3 = b2 + kstep;
            PG8_LDB(B0, 0, 0); PG8_LDB(B1, 0, 1); PG8_SCHED; PG8_LDA(At, 0, 0); PG8_STAGE(PG8_SA(1, 1), a1 + hstepA, voffA);
            PG8_WAIT_V(8); PG8_WAIT_L(0); PG8_BAR; PG8_MMA(0, 0, At, B0); PG8_MMA(0, 1, At, B1); PG8_BAR; PG8_SCHED;
            PG8_LDA(At, 0, 1); PG8_STAGE(PG8_SB(0, 0), b2, voffB); PG8_STAGE(PG8_SB(0, 1), b2 + hstepB, voffB); PG8_STAGE(PG8_SA(0, 0), a2, voffA);
            PG8_WAIT_V(8); PG8_WAIT_L(0); PG8_BAR; PG8_MMA(1, 0, At, B0); PG8_MMA(1, 1, At, B1); PG8_BAR; PG8_SCHED;
            PG8_LDB(B0, 1, 0); PG8_LDB(B1, 1, 1); PG8_SCHED; PG8_LDA(At, 1, 0); PG8_STAGE(PG8_SA(0, 1), a2 + hstepA, voffA);
            PG8_WAIT_V(8); PG8_WAIT_L(0); PG8_BAR; PG8_MMA(0, 0, At, B0); PG8_MMA(0, 1, At, B1); PG8_BAR; PG8_SCHED;
            PG8_LDA(At, 1, 1); PG8_STAGE(PG8_SB(1, 0), b3, voffB); PG8_STAGE(PG8_SB(1, 1), b3 + hstepB, voffB); PG8_STAGE(PG8_SA(1, 0), a3, voffA);
            PG8_WAIT_V(8); PG8_WAIT_L(0); PG8_BAR; PG8_MMA(1, 0, At, B0); PG8_MMA(1, 1, At, B1); PG8_BAR; PG8_SCHED;
        }
        if constexpr (ALIGN_EPI) { if (wr == 0) PG8_BAR; }
        E(acc, cur, wr, wc, fr, fq);
        if (!has_next) break;
#pragma unroll
        for (int a = 0; a < 2; ++a)
#pragma unroll
            for (int b = 0; b < 2; ++b)
#pragma unroll
                for (int m = 0; m < 4; ++m)
#pragma unroll
                    for (int n = 0; n < 2; ++n) acc[a][b][m][n] = (f32x4){0.f, 0.f, 0.f, 0.f};
        cur = nxt; cA = nA; cB = nB; ++ui;
        if constexpr (ALIGN_EPI) { if (wr == 1) PG8_BAR; }
    }
    PG8_WAIT_V(0);
    if constexpr (!ALIGN_EPI) { if (wr == 0) PG8_BAR; }
    PG8_BAR;
#undef PG8_SA
#undef PG8_SB
#undef PG8_STAGE
#undef PG8_LDA
#undef PG8_LDB
#undef PG8_MMA
#undef PG8_WAIT_V
#undef PG8_WAIT_L
#undef PG8_BAR
#undef PG8_SCHED
}
}

typedef f32x4 Acc[2][2][4][2];

struct EpiE {
    static constexpr bool PERM = true;
    bf16_t *U0, *BGA, *Q, *Kb, *VtC, *VtL, *SG; float *outk, *outv; const float *qg, *kg, *ropeC, *ropeS;
    __device__ __forceinline__ void operator()(const Acc& acc, const pg8::Unit& u, int wr, int wc, int fr, int fq) const {
        asm volatile("" : "+v"(fr), "+v"(fq));
        const int pn = u.pn, row0 = u.pm * 256 + wr * 64 + fr;
        if (pn < 8) {
            bf16_t* dst = (pn < 4 ? U0 : BGA) + (pn & 3) * 128 + wc * 32 + 8 * fq;
#pragma unroll
            for (int ai = 0; ai < 2; ++ai)
#pragma unroll
                for (int m = 0; m < 4; ++m) {
                    const int r = row0 + ai * 128 + m * 16;
                    f32x4 a0 = acc[ai][0][m][0], a1 = acc[ai][0][m][1], b0 = acc[ai][1][m][0], b1 = acc[ai][1][m][1];
                    if (pn >= 4) {
#pragma unroll
                        for (int i = 0; i < 4; ++i) { b0[i] = silu_f(b0[i]); b1[i] = silu_f(b1[i]); }
                    }
                    a0 = a0 * b0; a1 = a1 * b1;
                    u32x4 w; w.x = cvt_pk_bf16(a0[0], a0[1]); w.y = cvt_pk_bf16(a0[2], a0[3]); w.z = cvt_pk_bf16(a1[0], a1[1]); w.w = cvt_pk_bf16(a1[2], a1[3]);
                    *(u32x4*)(dst + (size_t)r * 512) = w;
                }
        } else if (pn < 10 || (pn == 10 && wc < 2)) {
            const bool isq = pn < 10, latent = u.pm >= 16;
            const int head = isq ? 4 * (pn - 8) + wc : wc;
            const float* gam = isq ? qg : kg;
            const float osc = isq ? 0.125f * LOG2E : 1.0f;
#pragma unroll
            for (int ai = 0; ai < 2; ++ai)
#pragma unroll
                for (int m = 0; m < 4; ++m) {
                    const int r = row0 + ai * 128 + m * 16;
                    f32x4 v[2][2]; float ss = 0.f;
#pragma unroll
                    for (int bj = 0; bj < 2; ++bj)
#pragma unroll
                        for (int n = 0; n < 2; ++n) { v[bj][n] = acc[ai][bj][m][n]; ss += (v[bj][n][0] * v[bj][n][0] + v[bj][n][1] * v[bj][n][1]) + (v[bj][n][2] * v[bj][n][2] + v[bj][n][3] * v[bj][n][3]); }
                    ss = rowsum4(ss);
                    const float rs = __builtin_amdgcn_rsqf(ss * (1.f / 64.f) + EPSN);
#pragma unroll
                    for (int bj = 0; bj < 2; ++bj)
#pragma unroll
                        for (int n = 0; n < 2; ++n) v[bj][n] = v[bj][n] * rs * (*(const f32x4*)(gam + 32 * bj + 16 * n + 4 * fq));
                    if (latent) {
                        const int t = (r - MCTX) & 2047;
#pragma unroll
                        for (int bj = 0; bj < 2; ++bj) {
                            const int pos = bj == 0 ? (t >> 6) : (t & 63);
                            const f32x4 cs = *(const f32x4*)(ropeC + pos * 16 + 4 * fq), sn = *(const f32x4*)(ropeS + pos * 16 + 4 * fq);
                            const f32x4 x1 = v[bj][0], x2 = v[bj][1];
                            v[bj][0] = x1 * cs - x2 * sn; v[bj][1] = x2 * cs + x1 * sn;
                        }
                    } else if (!isq) {
                        float* ok = outk + ((size_t)r * 2 + head) * 64 + 4 * fq;
#pragma unroll
                        for (int bj = 0; bj < 2; ++bj)
#pragma unroll
                            for (int n = 0; n < 2; ++n) *(f32x4*)(ok + 32 * bj + 16 * n) = v[bj][n];
                    }
                    bf16_t* dst = isq ? Q + (size_t)r * 512 + head * 64 : Kb + (size_t)r * 128 + head * 64;
#pragma unroll
                    for (int bj = 0; bj < 2; ++bj) {
                        const f32x4 a0 = v[bj][0] * osc, a1 = v[bj][1] * osc;
                        u32x4 w; w.x = cvt_pk_bf16(a0[0], a0[1]); w.y = cvt_pk_bf16(a0[2], a0[3]); w.z = cvt_pk_bf16(a1[0], a1[1]); w.w = cvt_pk_bf16(a1[2], a1[3]);
                        *(u32x4*)(dst + 32 * bj + 8 * fq) = w;
                    }
                    asm volatile("" ::: "memory");
                }
        } else if (pn == 10) {
            const int hv = wc - 2; const bool latent = u.pm >= 16;
#pragma unroll
            for (int ai = 0; ai < 2; ++ai)
#pragma unroll
                for (int m = 0; m < 4; ++m) {
                    const int r = row0 + ai * 128 + m * 16;
                    bf16_t* vt; int L;
                    if (latent) { const int b = (r - MCTX) >> 11, t = (r - MCTX) & 2047; vt = VtL + (size_t)(b * 2 + hv) * 64 * 2048 + (t >> 4) * 1024 + (t & 15); }
                    else { const int b = r >> 8, t = r & 255; vt = VtC + (size_t)(b * 2 + hv) * 64 * 256 + (t >> 4) * 1024 + (t & 15); }
                    L = 16;
#pragma unroll
                    for (int bj = 0; bj < 2; ++bj)
#pragma unroll
                        for (int n = 0; n < 2; ++n) {
                            const f32x4 x = acc[ai][bj][m][n]; const int d0 = 32 * bj + 8 * fq + 4 * n;
                            if (!latent) *(f32x4*)(outv + ((size_t)r * 2 + hv) * 64 + d0) = x;
                            const unsigned p0 = cvt_pk_bf16(x[0], x[1]), p1 = cvt_pk_bf16(x[2], x[3]);
                            vt[(size_t)(d0 + 0) * L] = (bf16_t)(p0 & 0xffffu); vt[(size_t)(d0 + 1) * L] = (bf16_t)(p0 >> 16);
                            vt[(size_t)(d0 + 2) * L] = (bf16_t)(p1 & 0xffffu); vt[(size_t)(d0 + 3) * L] = (bf16_t)(p1 >> 16);
                        }
                    asm volatile("" ::: "memory");
                }
        } else {
            bf16_t* dst = SG + (pn - 11) * 256 + wc * 32 + 8 * fq;
#pragma unroll
            for (int ai = 0; ai < 2; ++ai)
#pragma unroll
                for (int m = 0; m < 4; ++m) {
                    const int r = row0 + ai * 128 + m * 16;
#pragma unroll
                    for (int bj = 0; bj < 2; ++bj) {
                        f32x4 a0 = acc[ai][bj][m][0], a1 = acc[ai][bj][m][1];
#pragma unroll
                        for (int i = 0; i < 4; ++i) { a0[i] = silu_f(a0[i]); a1[i] = silu_f(a1[i]); }
                        u32x4 w; w.x = cvt_pk_bf16(a0[0], a0[1]); w.y = cvt_pk_bf16(a0[2], a0[3]); w.z = cvt_pk_bf16(a1[0], a1[1]); w.w = cvt_pk_bf16(a1[2], a1[3]);
                        *(u32x4*)(dst + (size_t)r * 512 + bj * 128) = w;
                    }
                }
        }
    }
};

struct EpiOut0 {
    static constexpr bool PERM = true;
    const float *xp, *xs, *ada0, *ada1, *g1; bf16_t* Y1; bf16_t* Y1G; float* rowss;
    __device__ __forceinline__ void operator()(const Acc& acc, const pg8::Unit& u, int wr, int wc, int fr, int fq) const {
        asm volatile("" : "+v"(fr), "+v"(fq));
        const int ci = u.pm < 16 ? 0 : 1 + ((u.pm - 16) >> 3);
        const int col0 = u.pn * 256 + wc * 32 + 8 * fq;
        f32x4 gate[2][2], gm[2][2];
#pragma unroll
        for (int bj = 0; bj < 2; ++bj)
#pragma unroll
            for (int n = 0; n < 2; ++n) { const int col = col0 + bj * 128 + n * 4;
                gate[bj][n] = *(const f32x4*)(ada0 + ci * 3072 + 2048 + col);
                gm[bj][n] = *(const f32x4*)(g1 + col) * (*(const f32x4*)(ada1 + ci * 3072 + 1024 + col) + 1.0f); }
#pragma unroll
        for (int ai = 0; ai < 2; ++ai)
#pragma unroll
            for (int m = 0; m < 4; ++m) {
                const int r = u.pm * 256 + ai * 128 + wr * 64 + m * 16 + fr;
                const float* xrow = r < MCTX ? xp + (size_t)r * DM : xs + (size_t)(r - MCTX) * DM;
                float ss = 0.f;
#pragma unroll
                for (int bj = 0; bj < 2; ++bj) { const int col = col0 + bj * 128;
                    f32x4 xa = __builtin_nontemporal_load((const f32x4*)(xrow + col - 4 * fq)), xb = __builtin_nontemporal_load((const f32x4*)(xrow + col - 4 * fq + 16));
                    line2own(xa, xb);
                    const f32x4 y0 = xa + gate[bj][0] * acc[ai][bj][m][0];
                    const f32x4 y1 = xb + gate[bj][1] * acc[ai][bj][m][1];
                    ss += ((y0[0] * y0[0] + y0[1] * y0[1]) + (y0[2] * y0[2] + y0[3] * y0[3])) + ((y1[0] * y1[0] + y1[1] * y1[1]) + (y1[2] * y1[2] + y1[3] * y1[3]));
                    u32x4 wy; wy.x = cvt_pk_bf16(y0[0], y0[1]); wy.y = cvt_pk_bf16(y0[2], y0[3]); wy.z = cvt_pk_bf16(y1[0], y1[1]); wy.w = cvt_pk_bf16(y1[2], y1[3]);
                    *(u32x4*)(Y1 + (size_t)r * DM + col) = wy;
                    const f32x4 g0 = y0 * gm[bj][0], g1v = y1 * gm[bj][1];
                    u32x4 w; w.x = cvt_pk_bf16(g0[0], g0[1]); w.y = cvt_pk_bf16(g0[2], g0[3]); w.z = cvt_pk_bf16(g1v[0], g1v[1]); w.w = cvt_pk_bf16(g1v[2], g1v[3]);
                    *(u32x4*)(Y1G + (size_t)r * DM + col) = w; }
                ss = rowsum4(ss);
                if (fq == 0) atomicAdd(rowss + r, ss);
                asm volatile("" ::: "memory");
            }
    }
};

struct EpiOdd {
    static constexpr bool PERM = true;
    const float *rowss, *sb; bf16_t *U1, *SG2;
    __device__ __forceinline__ void operator()(const Acc& acc, const pg8::Unit& u, int wr, int wc, int fr, int fq) const {
        asm volatile("" : "+v"(fr), "+v"(fq));
        const int ci = u.pm < 16 ? 0 : 1 + ((u.pm - 16) >> 3);
        const int col0 = u.pn * 256 + wc * 32 + 8 * fq;
        f32x4 sbv[2][2];
#pragma unroll
        for (int bj = 0; bj < 2; ++bj)
#pragma unroll
            for (int n = 0; n < 2; ++n) sbv[bj][n] = *(const f32x4*)(sb + ci * NO + col0 + bj * 128 + 4 * n);
        const bool isg = u.pn >= 4;
        bf16_t* dst = isg ? SG2 + (col0 - 1024) : U1 + col0;
#pragma unroll
        for (int ai = 0; ai < 2; ++ai)
#pragma unroll
            for (int m = 0; m < 4; ++m) {
                const int r = u.pm * 256 + ai * 128 + wr * 64 + m * 16 + fr;
                const float rstd = __builtin_amdgcn_rsqf(rowss[r] * (1.f / 1024.f) + EPSN);
#pragma unroll
                for (int bj = 0; bj < 2; ++bj) {
                    f32x4 a0 = acc[ai][bj][m][0] * rstd + sbv[bj][0], a1 = acc[ai][bj][m][1] * rstd + sbv[bj][1];
                    if (isg) {
#pragma unroll
                        for (int i = 0; i < 4; ++i) { a0[i] = silu_f(a0[i]); a1[i] = silu_f(a1[i]); }
                    }
                    u32x4 w; w.x = cvt_pk_bf16(a0[0], a0[1]); w.y = cvt_pk_bf16(a0[2], a0[3]); w.z = cvt_pk_bf16(a1[0], a1[1]); w.w = cvt_pk_bf16(a1[2], a1[3]);
                    *(u32x4*)(dst + (size_t)r * DM + bj * 128) = w;
                }
            }
    }
};

struct EpiPool {
    static constexpr bool PERM = true;
    const float* pscale; const bf16_t* SG2; bf16_t* A4;
    __device__ __forceinline__ void operator()(const Acc& acc, const pg8::Unit& u, int wr, int wc, int fr, int fq) const {
        asm volatile("" : "+v"(fr), "+v"(fq));
        const int col0 = u.pn * 256 + wc * 32 + 8 * fq;
        f32x4 ps[2][2];
#pragma unroll
        for (int bj = 0; bj < 2; ++bj)
#pragma unroll
            for (int n = 0; n < 2; ++n) ps[bj][n] = *(const f32x4*)(pscale + col0 + bj * 128 + 4 * n);
#pragma unroll
        for (int ai = 0; ai < 2; ++ai)
#pragma unroll
            for (int m = 0; m < 4; ++m) {
                const int r = u.pm * 256 + ai * 128 + wr * 64 + m * 16 + fr;
#pragma unroll
                for (int bj = 0; bj < 2; ++bj) {
                    const u32x4 sg = *(const u32x4*)(SG2 + (size_t)r * DM + col0 + bj * 128);
                    f32x4 a0 = acc[ai][bj][m][0] * ps[bj][0], a1 = acc[ai][bj][m][1] * ps[bj][1];
                    a0[0] *= bf_lo(sg.x); a0[1] *= bf_hi(sg.x); a0[2] *= bf_lo(sg.y); a0[3] *= bf_hi(sg.y);
                    a1[0] *= bf_lo(sg.z); a1[1] *= bf_hi(sg.z); a1[2] *= bf_lo(sg.w); a1[3] *= bf_hi(sg.w);
                    u32x4 w; w.x = cvt_pk_bf16(a0[0], a0[1]); w.y = cvt_pk_bf16(a0[2], a0[3]); w.z = cvt_pk_bf16(a1[0], a1[1]); w.w = cvt_pk_bf16(a1[2], a1[3]);
                    *(u32x4*)(A4 + (size_t)r * DM + col0 + bj * 128) = w;
                }
                asm volatile("" ::: "memory");
            }
    }
};

struct EpiFinal {
    static constexpr bool PERM = true;
    const bf16_t* Y1; const float* ada1; float* out;
    __device__ __forceinline__ void operator()(const Acc& acc, const pg8::Unit& u, int wr, int wc, int fr, int fq) const {
        asm volatile("" : "+v"(fr), "+v"(fq));
        const int ci = u.pm < 16 ? 0 : 1 + ((u.pm - 16) >> 3);
        const int col0 = u.pn * 256 + wc * 32 + 8 * fq;
        f32x4 gate[2][2];
#pragma unroll
        for (int bj = 0; bj < 2; ++bj)
#pragma unroll
            for (int n = 0; n < 2; ++n) gate[bj][n] = *(const f32x4*)(ada1 + ci * 3072 + 2048 + col0 + bj * 128 + n * 4);
#pragma unroll
        for (int ai = 0; ai < 2; ++ai)
#pragma unroll
            for (int m = 0; m < 4; ++m) {
                const size_t ro = (size_t)(u.pm * 256 + ai * 128 + wr * 64 + m * 16 + fr) * DM;
#pragma unroll
                for (int bj = 0; bj < 2; ++bj) { const int col = col0 + bj * 128;
                    const u32x4 yb = *(const u32x4*)(Y1 + ro + col);
                    const f32x4 ya = {bf_lo(yb.x), bf_hi(yb.x), bf_lo(yb.y), bf_hi(yb.y)}, yc = {bf_lo(yb.z), bf_hi(yb.z), bf_lo(yb.w), bf_hi(yb.w)};
                    f32x4 oa = ya + gate[bj][0] * acc[ai][bj][m][0], ob = yc + gate[bj][1] * acc[ai][bj][m][1];
                    own2line(oa, ob);
                    __builtin_nontemporal_store(oa, (f32x4*)(out + ro + col - 4 * fq));
                    __builtin_nontemporal_store(ob, (f32x4*)(out + ro + col - 4 * fq + 16)); }
                if (m & 1) asm volatile("" ::: "memory");
            }
    }
};

__device__ __forceinline__ int colmap_e(int np) {
    const int pn = np >> 8, c = np & 255, bj = c >> 7, wc = (c >> 5) & 3, w = c & 31;
    if (pn < 4) return (bj ? 1024 : 512) + pn * 128 + (c & 127);
    if (pn < 8) return (bj ? 1536 : 0) + (pn - 4) * 128 + (c & 127);
    const int fq = w >> 3, n = (w >> 2) & 1, i = w & 3, d = 32 * bj + 16 * n + 4 * fq + i;
    if (pn < 10) return 2048 + (4 * (pn - 8) + wc) * 64 + d;
    if (pn == 10) { if (wc < 2) return 2560 + wc * 64 + d; return 2688 + (wc - 2) * 64 + 32 * bj + w; }
    return 2816 + (pn - 11) * 256 + c;
}
__device__ __forceinline__ unsigned f2bf(float f) { unsigned u = __float_as_uint(f); return (u + 0x7fffu + ((u >> 16) & 1u)) >> 16; }
__device__ __forceinline__ unsigned pk2(float lo, float hi) { return f2bf(lo) | (f2bf(hi) << 16); }
template <bool PERME>
__device__ __forceinline__ void transpose_item(const float* W, int K, int N, bf16_t* WT, int row_off, LAS float* scr, int item, int lane) {
    const int nblk = N / 32, kb = item / nblk, nb = item % nblk, k0 = 64 * kb, n0 = 32 * nb;
    const int srcc = PERME ? colmap_e(n0 + (lane & 31)) : n0 + (lane & 31);
#pragma unroll 8
    for (int i = 0; i < 32; ++i) { const int kk = 2 * i + (lane >> 5); scr[kk * 33 + (lane & 31)] = __builtin_nontemporal_load(W + (size_t)(k0 + kk) * N + srcc); }
    asm volatile("s_waitcnt lgkmcnt(0)" ::: "memory");
    const int c = lane & 7;
#pragma unroll
    for (int j = 0; j < 4; ++j) { const int n = (lane >> 3) + 8 * j; const LAS float* s = scr + (8 * c) * 33 + n;
        u32x4 o; o.x = pk2(s[0 * 33], s[1 * 33]); o.y = pk2(s[2 * 33], s[3 * 33]); o.z = pk2(s[4 * 33], s[5 * 33]); o.w = pk2(s[6 * 33], s[7 * 33]);
        *(u32x4*)(WT + (size_t)(row_off + n0 + n) * K + k0 + 8 * c) = o; }
    asm volatile("s_waitcnt lgkmcnt(0)" ::: "memory");
}
__device__ __forceinline__ void gemv_block(LAS unsigned char* lds, const float* W, int N, int n0, const float* bias, float* out, int out_stride) {
    LAS float* s = (LAS float*)lds; LAS float* red = (LAS float*)(lds + 20480);
    const int tid = threadIdx.x, col = tid & 31, ks = tid >> 5;
    float a[5] = {0.f, 0.f, 0.f, 0.f, 0.f};
    const float* wp = W + (size_t)(ks * 64) * N + n0 + col;
#pragma unroll 16
    for (int k = 0; k < 64; ++k) { const float w = __builtin_nontemporal_load(wp + (size_t)k * N);
#pragma unroll
        for (int ci = 0; ci < 5; ++ci) a[ci] += s[ci * 1024 + ks * 64 + k] * w; }
#pragma unroll
    for (int ci = 0; ci < 5; ++ci) red[(ks * 5 + ci) * 32 + col] = a[ci];
    __syncthreads();
    if (tid < 160) { const int ci = tid >> 5; float t = bias ? bias[n0 + col] : 0.f;
#pragma unroll
        for (int k2 = 0; k2 < 16; ++k2) t += red[(k2 * 5 + ci) * 32 + col];
        out[ci * out_stride + n0 + col] = t; }
    __syncthreads();
}

struct AttnP { const bf16_t *Q, *K, *KC, *VtC, *VtL, *VCt, *SG; bf16_t* A2; const float* sink; };
constexpr int NH = 2;
#define MFMA16(a, b, c) __builtin_amdgcn_mfma_f32_16x16x32_bf16((a), (b), (c), 0, 0, 0)
__device__ __forceinline__ void attn_loadk(bf16x8 (&kf)[2][2], const bf16_t* kb, int k0, int Lk, int c16, int kq) {
#pragma unroll
    for (int kt = 0; kt < 2; ++kt) { int key = k0 + 8 * (c16 >> 2) + 4 * kt + (c16 & 3); key = key < 0 ? 0 : (key > Lk - 1 ? Lk - 1 : key);
#pragma unroll
        for (int ks = 0; ks < 2; ++ks) kf[kt][ks] = *(const bf16x8*)(kb + (size_t)key * 128 + 32 * ks + 8 * kq); }
}
__device__ __forceinline__ void attn_loadv(bf16x8 (&vf)[4], const bf16_t* vb, int k0, int Lk, int c16, int kq) {
    int tok = k0 + 8 * kq; tok = tok < 0 ? 0 : (tok > Lk - 8 ? Lk - 8 : tok);
#pragma unroll
    for (int dt = 0; dt < 4; ++dt) vf[dt] = *(const bf16x8*)(vb + (size_t)(tok >> 4) * 1024 + (16 * dt + c16) * 16 + (tok & 15));
}

__device__ __forceinline__ void rowpair(unsigned& m0, unsigned& m1) {
    u32x2p r = __builtin_amdgcn_permlane32_swap(m0, m1, false, false); m0 = r.x; m1 = r.y;
    r = __builtin_amdgcn_permlane16_swap(m0, m1, false, false); m0 = r.x; m1 = r.y;
}
__device__ __forceinline__ void attn_mask(f32x4& s0, f32x4& s1, int mode, int k0, int Lk, int tq, int kq) {
#pragma unroll
    for (int j = 0; j < 4; ++j) { const int ka = k0 + 8 * kq + j, kb2 = ka + 4; const int da = tq - ka, db = tq - kb2;
        const bool va = mode == 1 && ka >= 0 && ka < Lk && da <= 128 && da >= -128, vb2 = mode == 1 && kb2 >= 0 && kb2 < Lk && db <= 128 && db >= -128;
        s0[j] = va ? s0[j] : -1e30f; s1[j] = vb2 ? s1[j] : -1e30f; }
}
__device__ __forceinline__ void attn_compute(f32x4 (&o)[NH][4], float (&m2)[NH], float (&l)[NH], const bf16x8 (&qf)[NH][2],
                                             const bf16x8 (&kfA)[2][2], const bf16x8 (&vfA)[4], const bf16x8 (&kfB)[2][2], const bf16x8 (&vfB)[4],
                                             int modeA, int k0A, int LkA, int modeB, int k0B, int LkB, int tq, int kq) {
#pragma unroll
    for (int hq = 0; hq < NH; ++hq) {
        const f32x4 z = {0.f, 0.f, 0.f, 0.f};
        f32x4 a0 = MFMA16(kfA[0][0], qf[hq][0], z); a0 = MFMA16(kfA[0][1], qf[hq][1], a0);
        f32x4 a1 = MFMA16(kfA[1][0], qf[hq][0], z); a1 = MFMA16(kfA[1][1], qf[hq][1], a1);
        f32x4 b0 = MFMA16(kfB[0][0], qf[hq][0], z); b0 = MFMA16(kfB[0][1], qf[hq][1], b0);
        f32x4 b1 = MFMA16(kfB[1][0], qf[hq][0], z); b1 = MFMA16(kfB[1][1], qf[hq][1], b1);
        if (modeA) attn_mask(a0, a1, modeA, k0A, LkA, tq, kq);
        if (modeB) attn_mask(b0, b1, modeB, k0B, LkB, tq, kq);
        float mx = fmaxf(fmaxf(fmaxf(fmaxf(a0[0], a0[1]), fmaxf(a0[2], a0[3])), fmaxf(fmaxf(a1[0], a1[1]), fmaxf(a1[2], a1[3]))),
                         fmaxf(fmaxf(fmaxf(b0[0], b0[1]), fmaxf(b0[2], b0[3])), fmaxf(fmaxf(b1[0], b1[1]), fmaxf(b1[2], b1[3]))));
        mx = rowmax4(mx);
        if (__builtin_amdgcn_ballot_w64(mx > m2[hq] + 8.0f) != 0ull) {
            const float mn = fmaxf(m2[hq], mx), alpha = __builtin_amdgcn_exp2f(m2[hq] - mn); m2[hq] = mn; l[hq] *= alpha;
#pragma unroll
            for (int dt = 0; dt < 4; ++dt) o[hq][dt] = o[hq][dt] * alpha;
        }
        const float mr = m2[hq];
        float ps = 0.f;
#pragma unroll
        for (int j = 0; j < 4; ++j) { a0[j] = __builtin_amdgcn_exp2f(a0[j] - mr); a1[j] = __builtin_amdgcn_exp2f(a1[j] - mr); b0[j] = __builtin_amdgcn_exp2f(b0[j] - mr); b1[j] = __builtin_amdgcn_exp2f(b1[j] - mr); }
        ps = ((a0[0] + a0[1]) + (a0[2] + a0[3])) + ((a1[0] + a1[1]) + (a1[2] + a1[3])) + (((b0[0] + b0[1]) + (b0[2] + b0[3])) + ((b1[0] + b1[1]) + (b1[2] + b1[3])));
        l[hq] += ps;
        u32x4 pa, pb; pa.x = cvt_pk_bf16(a0[0], a0[1]); pa.y = cvt_pk_bf16(a0[2], a0[3]); pa.z = cvt_pk_bf16(a1[0], a1[1]); pa.w = cvt_pk_bf16(a1[2], a1[3]);
        pb.x = cvt_pk_bf16(b0[0], b0[1]); pb.y = cvt_pk_bf16(b0[2], b0[3]); pb.z = cvt_pk_bf16(b1[0], b1[1]); pb.w = cvt_pk_bf16(b1[2], b1[3]);
        const bf16x8 pfa = __builtin_bit_cast(bf16x8, pa), pfb = __builtin_bit_cast(bf16x8, pb);
#pragma unroll
        for (int dt = 0; dt < 4; ++dt) { o[hq][dt] = MFMA16(vfA[dt], pfa, o[hq][dt]); o[hq][dt] = MFMA16(vfB[dt], pfb, o[hq][dt]); }
    }
}

__device__ __forceinline__ void attn_unit(LAS unsigned char* lds, const AttnP& P, bool latent, int b, int kvh, int hq0, int q0, int lane, int pflags = 0) {
    const int c16 = lane & 15, kq = lane >> 4;
    const int L = latent ? 2048 : 256;
    const int rowbase = latent ? MCTX + b * 2048 : b * 256;
    const int qrow = rowbase + q0 + c16, tq = q0 + c16;
    bf16x8 qf[NH][2];
#pragma unroll
    for (int hq = 0; hq < NH; ++hq)
#pragma unroll
        for (int ks = 0; ks < 2; ++ks) qf[hq][ks] = *(const bf16x8*)(P.Q + (size_t)qrow * 512 + (4 * kvh + hq0 + hq) * 64 + 32 * ks + 8 * kq);
    u32x2 sgv[NH][4];
#pragma unroll
    for (int hq = 0; hq < NH; ++hq)
#pragma unroll
        for (int dt = 0; dt < 4; ++dt) sgv[hq][dt] = *(const u32x2*)(P.SG + (size_t)qrow * 512 + (4 * kvh + hq0 + hq) * 64 + 16 * dt + 4 * kq);
    f32x4 o[NH][4]; float m2[NH], l[NH];
#pragma unroll
    for (int hq = 0; hq < NH; ++hq) { m2[hq] = P.sink[4 * kvh + hq0 + hq] * LOG2E; l[hq] = kq == 0 ? 1.f : 0.f;
#pragma unroll
        for (int dt = 0; dt < 4; ++dt) o[hq][dt] = (f32x4){0.f, 0.f, 0.f, 0.f}; }
    const bf16_t* Kl = P.K + (size_t)rowbase * 128 + kvh * 64;
    const bf16_t* Vl = latent ? P.VtL + (size_t)(b * 2 + kvh) * 64 * 2048 : P.VtC + (size_t)(b * 2 + kvh) * 64 * 256;
    const bf16_t* Kc = P.KC + (size_t)b * 256 * 128 + kvh * 64;
    const bf16_t* Vc = P.VCt + (size_t)(b * 2 + kvh) * 64 * 256;
    int kloc0, nloc, nh;
    if (latent) { int st_lo = (128 - q0) / 32; if (st_lo < 0 || q0 > 128) st_lo = 0; int st_hi = (2176 - q0 + 31) / 32; if (st_hi > 9) st_hi = 9;
        kloc0 = q0 - 128 + 32 * st_lo; nloc = st_hi - st_lo; nh = nloc + 8; }
    else { kloc0 = 0; nloc = 8; nh = 8; }
    const int nsteps = (nh + 1) >> 1;
#define HSRC(h, kb_, vb_, k0_, Lk_, md_) const int hh_##k0_ = (h) < nh ? (h) : nh - 1; const bool lc_##k0_ = hh_##k0_ < nloc; \
        const bf16_t* kb_ = lc_##k0_ ? Kl : Kc; const bf16_t* vb_ = lc_##k0_ ? Vl : Vc; const int k0_ = lc_##k0_ ? kloc0 + 32 * hh_##k0_ : 32 * (hh_##k0_ - nloc); const int Lk_ = lc_##k0_ ? L : 256; \
        const int md_ = (h) >= nh ? 2 : ((latent && lc_##k0_ && (k0_ < 0 || k0_ + 32 > L || k0_ < q0 - 112 || k0_ + 31 > q0 + 128)) ? 1 : 0)
    bf16x8 kfA[2][2], kfB[2][2], knA[2][2], knB[2][2];
    { HSRC(0, kbA_, vbA_, k0A_, LkA_, mdA_); HSRC(1, kbB_, vbB_, k0B_, LkB_, mdB_); (void)vbA_; (void)vbB_; (void)mdA_; (void)mdB_;
      attn_loadk(kfA, kbA_, k0A_, LkA_, c16, kq); attn_loadk(kfB, kbB_, k0B_, LkB_, c16, kq); }
    for (int st = 0; st < nsteps; ++st) {
        bf16x8 vfA[4], vfB[4];
        HSRC(2 * st, kbA, vbA, k0A, LkA, mdA); HSRC(2 * st + 1, kbB, vbB, k0B, LkB, mdB); (void)kbA; (void)kbB;
        attn_loadv(vfA, vbA, k0A, LkA, c16, kq); attn_loadv(vfB, vbB, k0B, LkB, c16, kq);
        { HSRC(2 * st + 2, kbC, vbC, k0C, LkC, mdC); HSRC(2 * st + 3, kbD, vbD, k0D, LkD, mdD); (void)vbC; (void)vbD; (void)mdC; (void)mdD;
          attn_loadk(knA, kbC, k0C, LkC, c16, kq); attn_loadk(knB, kbD, k0D, LkD, c16, kq); }
        __builtin_amdgcn_sched_barrier(0);
        attn_compute(o, m2, l, qf, kfA, vfA, kfB, vfB, mdA, k0A, LkA, mdB, k0B, LkB, tq, kq);
#pragma unroll
        for (int kt = 0; kt < 2; ++kt) { kfA[kt][0] = knA[kt][0]; kfA[kt][1] = knA[kt][1]; kfB[kt][0] = knB[kt][0]; kfB[kt][1] = knB[kt][1]; }
    }
#undef HSRC
#pragma unroll
    for (int hq = 0; hq < NH; ++hq) {
        const float lt = rowsum4(l[hq]);
        const float inv = 1.f / lt;
        unsigned wx[4], wy[4];
#pragma unroll
        for (int dt = 0; dt < 4; ++dt) {
            const u32x2 sg = sgv[hq][dt];
            const f32x4 v = o[hq][dt] * inv;
            wx[dt] = cvt_pk_bf16(v[0] * bf_lo(sg.x), v[1] * bf_hi(sg.x)); wy[dt] = cvt_pk_bf16(v[2] * bf_lo(sg.y), v[3] * bf_hi(sg.y));
        }
        rowpair(wx[0], wx[1]); rowpair(wy[0], wy[1]); rowpair(wx[2], wx[3]); rowpair(wy[2], wy[3]);
        bf16_t* dst = P.A2 + (size_t)qrow * DM + 512 + (4 * kvh + hq0 + hq) * 64 + 8 * kq;
        if (!(pflags & 8)) { *(u32x4*)dst = (u32x4){wx[0], wy[0], wx[1], wy[1]}; *(u32x4*)(dst + 32) = (u32x4){wx[2], wy[2], wx[3], wy[3]}; }
    }
}

__device__ __forceinline__ void load8(const bf16_t* p, float (&v)[8]) { const u32x4 w = *(const u32x4*)p; v[0] = bf_lo(w.x); v[1] = bf_hi(w.x); v[2] = bf_lo(w.y); v[3] = bf_hi(w.y); v[4] = bf_lo(w.z); v[5] = bf_hi(w.z); v[6] = bf_lo(w.w); v[7] = bf_hi(w.w); }
__device__ __forceinline__ void unpack8(const u32x4 w, float (&v)[8]) { v[0] = bf_lo(w.x); v[1] = bf_hi(w.x); v[2] = bf_lo(w.y); v[3] = bf_hi(w.y); v[4] = bf_lo(w.z); v[5] = bf_hi(w.z); v[6] = bf_lo(w.w); v[7] = bf_hi(w.w); }
__device__ __forceinline__ void store8(bf16_t* p, const float (&v)[8]) { u32x4 w; w.x = cvt_pk_bf16(v[0], v[1]); w.y = cvt_pk_bf16(v[2], v[3]); w.z = cvt_pk_bf16(v[4], v[5]); w.w = cvt_pk_bf16(v[6], v[7]); *(u32x4*)p = w; }
__device__ __forceinline__ void conv_item(const bf16_t* U0, const bf16_t* BGA, bf16_t* A2, const float* cw, const float* cb, int item, int lane) {
    const int c = 8 * lane, r0 = 4 * item;
    const int t0 = r0 < MCTX ? (r0 & 255) : ((r0 - MCTX) & 2047), L = r0 < MCTX ? 256 : 2048;
    u32x4 ur[6], gr[4];
#pragma unroll
    for (int i = 0; i < 6; ++i) { const int t = t0 - 1 + i; const int rr = r0 - 1 + i + (t < 0 ? 1 : 0) - (t >= L ? 1 : 0); ur[i] = *(const u32x4*)(U0 + (size_t)rr * 512 + c); if (t < 0 || t >= L) ur[i] = (u32x4){0u, 0u, 0u, 0u}; }
#pragma unroll
    for (int i = 0; i < 4; ++i) gr[i] = *(const u32x4*)(BGA + (size_t)(r0 + i) * 512 + c);
    float w0[8], w1[8], w2[8], bb[8];
#pragma unroll
    for (int i = 0; i < 8; ++i) { w0[i] = cw[c + i]; w1[i] = cw[512 + c + i]; w2[i] = cw[1024 + c + i]; bb[i] = cb[c + i]; }
#pragma unroll
    for (int i = 0; i < 4; ++i) {
        float pv[8], cu[8], nx[8], g[8], y[8];
        unpack8(ur[i], pv); unpack8(ur[i + 1], cu); unpack8(ur[i + 2], nx); unpack8(gr[i], g);
#pragma unroll
        for (int k = 0; k < 8; ++k) y[k] = g[k] * (w0[k] * pv[k] + w1[k] * cu[k] + w2[k] * nx[k] + bb[k]);
        store8(A2 + (size_t)(r0 + i) * DM + c, y);
    }
}

template <int H>
__device__ __forceinline__ void pool_item_t(const bf16_t* U1, bf16_t* PO, int gi, int chunk, int lane) {
    constexpr int R = 4, NR = R - 1 + 2 * H;
    const int hw = lane >> 5, c = gi * 256 + 8 * (lane & 31), r0 = chunk * (2 * R) + R * hw;
    const int rs = r0 < MCTX ? (r0 & ~255) : MCTX + ((r0 - MCTX) & ~2047), L = r0 < MCTX ? 256 : 2048, t0 = r0 - rs;
    const bf16_t* base = U1 + (size_t)rs * DM + c;
    u32x4 raw[NR];
#pragma unroll
    for (int i = 0; i < NR; ++i) { const int t = t0 - H + i; const int tc = t < 0 ? 0 : (t > L - 1 ? L - 1 : t); raw[i] = *(const u32x4*)(base + (size_t)tc * DM); if (t < 0 || t >= L) raw[i] = (u32x4){0u, 0u, 0u, 0u}; }
    float S[8];
#pragma unroll
    for (int k = 0; k < 8; ++k) S[k] = 0.f;
#pragma unroll
    for (int i = 0; i < 2 * H; ++i) { float v[8]; unpack8(raw[i], v);
#pragma unroll
        for (int k = 0; k < 8; ++k) S[k] += v[k]; }
#pragma unroll
    for (int tt = 0; tt < R; ++tt) {
        const int t = t0 + tt, lo = t - H > 0 ? t - H : 0, hi = t + H < L ? t + H : L;
        const float rc = 1.f / (float)(hi - lo);
        float uc[8], y[8]; unpack8(raw[tt + H], uc);
#pragma unroll
        for (int k = 0; k < 8; ++k) y[k] = S[k] * rc - uc[k];
        store8(PO + (size_t)(rs + t) * DM + c, y);
        if (tt < R - 1) { float va[8], vs[8]; unpack8(raw[tt + 2 * H], va); unpack8(raw[tt], vs);
#pragma unroll
            for (int k = 0; k < 8; ++k) S[k] += va[k] - vs[k]; }
    }
}
__device__ __forceinline__ void pool_item(const bf16_t* U1, bf16_t* PO, int item, int lane, bool direct = false) {
    const int chunk = item >> 2, gi = direct ? (item & 3) : ((item + (item >> 11)) & 3);
    if (gi == 0) pool_item_t<1>(U1, PO, 0, chunk, lane);
    else if (gi == 1) pool_item_t<2>(U1, PO, 1, chunk, lane);
    else if (gi == 2) pool_item_t<4>(U1, PO, 2, chunk, lane);
    else pool_item_t<8>(U1, PO, 3, chunk, lane);
}


#define XB_TMO      128
#define XB_XCNT(j)  (256  + 64 * (j))
#define XB_XSUB(j)  (1280 + 64 * (j))
#define XB_XGEN(j)  (2304 + 64 * (j))
#define XB_TOP      3328
#define XB_TOPGEN   3392
#define XCD_BAR_WORDS 3456
#define XB_SPIN_CAP (1u << 18)
__device__ __forceinline__ unsigned xb_ld(unsigned* p)              { return __hip_atomic_load(p, __ATOMIC_RELAXED, __HIP_MEMORY_SCOPE_AGENT); }
__device__ __forceinline__ unsigned xb_add(unsigned* p, unsigned v) { return __hip_atomic_fetch_add(p, v, __ATOMIC_RELAXED, __HIP_MEMORY_SCOPE_AGENT); }
__device__ __forceinline__ unsigned xb_xcc_id() { return (unsigned)__builtin_amdgcn_s_getreg((3 << 11) | 20) & 0xFu; }
#define XB_SPIN(cond, bar) do { unsigned _sp = 0; while (cond) { __builtin_amdgcn_s_sleep(1); \
    if ((++_sp & 255u) == 0u) { if (xb_ld(&(bar)[XB_TMO])) break; if (_sp > XB_SPIN_CAP) { atomicAdd(&(bar)[XB_TMO], 1u); break; } } } } while (0)
struct XcdBarrier { unsigned* bar; unsigned x; volatile LAS unsigned* st; };
#define XB_DONE 3520
__device__ unsigned g_bar[4096];
__device__ __forceinline__ XcdBarrier xcd_barrier_post(unsigned* bar, volatile LAS unsigned* st) {
    XcdBarrier b; b.bar = bar; b.x = xb_xcc_id(); b.st = st;
    if (threadIdx.x == 0) (void)xb_add(&bar[XB_XCNT(b.x)], 1u);
    return b;
}
__device__ __forceinline__ void xcd_barrier_complete(unsigned* bar, unsigned x, unsigned& nloc, unsigned& nx) {
    const unsigned G = gridDim.x * gridDim.y * gridDim.z;
    unsigned sum, cnt, mine, sp = 0u;
    for (;;) {
        sum = 0u; cnt = 0u; mine = 0u;
#pragma unroll
        for (unsigned j = 0; j < 16; ++j) { const unsigned c = xb_ld(&bar[XB_XCNT(j)]); sum += c; cnt += (c > 0u) ? 1u : 0u; mine = (j == x) ? c : mine; }
        if (sum == G) break;
        __builtin_amdgcn_s_sleep(1);
        if ((++sp & 255u) == 0u) { if (xb_ld(&bar[XB_TMO])) break; if (sp > XB_SPIN_CAP) { atomicAdd(&bar[XB_TMO], 1u); break; } }
    }
    nloc = mine > 0u ? mine : 1u; nx = cnt > 0u ? cnt : 1u;
}
__device__ __forceinline__ void xcd_barrier(const XcdBarrier& b) {
    asm volatile("s_waitcnt vmcnt(0)" ::: "memory");
    __syncthreads();
    if (threadIdx.x == 0) {
        unsigned* bar = b.bar;
        __builtin_amdgcn_s_waitcnt(0);
        unsigned nloc = b.st[0], nx = b.st[1];
        if (nloc == 0u) { xcd_barrier_complete(bar, b.x, nloc, nx); b.st[0] = nloc; b.st[1] = nx; }
        const unsigned old = xb_add(&bar[XB_XSUB(b.x)], 1u);
        const unsigned gen = old / nloc;
        if (old + 1u == (gen + 1u) * nloc) {
            __builtin_amdgcn_fence(__ATOMIC_RELEASE, "agent");
            asm volatile("s_waitcnt vmcnt(0)" ::: "memory");
            const unsigned og = xb_add(&bar[XB_TOP], 1u);
            const unsigned tg = og / nx;
            if (og + 1u == (tg + 1u) * nx) xb_add(&bar[XB_TOPGEN], 1u);
            else XB_SPIN(xb_ld(&bar[XB_TOPGEN]) == tg, bar);
            __builtin_amdgcn_fence(__ATOMIC_ACQUIRE, "agent");
            xb_add(&bar[XB_XGEN(b.x)], 1u);
            asm volatile("s_waitcnt vmcnt(0)" ::: "memory");
        } else {
            XB_SPIN(xb_ld(&bar[XB_XGEN(b.x)]) == gen, bar);
            __builtin_amdgcn_fence(__ATOMIC_ACQUIRE, "agent");
            asm volatile("s_waitcnt vmcnt(0)" ::: "memory");
        }
    }
    __syncthreads();
}

struct Args { const float* in[23]; float* out; unsigned char* ws; int ph_lo, ph_hi, coop, pad; };
enum { I_XP = 0, I_XS, I_CK, I_CV, I_C, I_CCTX, I_ADAWE, I_ADABE, I_NGE, I_WINE, I_CONVW, I_CONVB, I_QG, I_KG, I_SINK, I_WOUTE, I_ADAWO, I_ADABO, I_NGO, I_WINO, I_POOLW, I_PSCALE, I_WOUTO };

typedef const __attribute__((address_space(4))) Args* KArgs;
__device__ __forceinline__ KArgs opaque_args(KArgs p) { asm volatile("" : "+s"(p)); return p; }
#define WSP(T, off) ((T*)(A->ws + (off)))

__global__ void __launch_bounds__(512) mk_fwd(Args a_) {
    extern __shared__ __attribute__((aligned(16))) unsigned char lds_raw[];
    LAS unsigned char* lds = (LAS unsigned char*)lds_raw;
    cg::grid_group grid = cg::this_grid();
    KArgs ap = (KArgs)__builtin_amdgcn_kernarg_segment_ptr();
    const int G = gridDim.x, bx = blockIdx.x;
    const int lo = ap->ph_lo, hi = ap->ph_hi;
#define TIDS const int tid = threadIdx.x, lane = tid & 63, wave = __builtin_amdgcn_readfirstlane(tid >> 6); (void)lane; (void)wave
#ifndef PHM
#define PHM 0x1ff
#endif
#define IN(k) (((PHM >> (k)) & 1) && lo <= (k) && (k) < hi)
    volatile LAS unsigned* bst = (volatile LAS unsigned*)(lds + 131072);
    if (threadIdx.x < 4) bst[threadIdx.x] = 0u;
    __syncthreads();
    XcdBarrier xbar; xbar.bar = g_bar; xbar.x = 0; xbar.st = bst;
    if (ap->coop == 1) xbar = xcd_barrier_post(g_bar, bst);
    if (ap->coop == 2) grid.sync();
#define SEAM(k) do { if (IN(k) && IN((k) + 1)) xcd_barrier(xbar); } while (0)

    for (int rep_ = 0, nrep_ = (PROBE_PH == 0 ? 1 + ap->pad : 1); rep_ < nrep_; ++rep_) { if (rep_) xcd_barrier(xbar);
    if (IN(0)) {
        KArgs A = opaque_args(ap); TIDS;
        float* ADA = WSP(float, WS_ADA); float* ROPE = WSP(float, WS_ROPE); float* ROWSS = WSP(float, WS_ROWSS); bf16_t* KC = WSP(bf16_t, WS_KC); bf16_t* VCT = WSP(bf16_t, WS_VCT);
        bf16_t* WE = WSP(bf16_t, WS_WE); bf16_t* WOE = WSP(bf16_t, WS_WOE); bf16_t* WIO = WSP(bf16_t, WS_WIO); bf16_t* PW = WSP(bf16_t, WS_PW); bf16_t* WOO = WSP(bf16_t, WS_WOO);

        const int gt = bx * 512 + tid, NT = G * 512;
        for (int i = gt; i < MROWS; i += NT) ROWSS[i] = 0.f;
        for (int i = gt; i < 131072; i += NT) {
            { const int p = i & 63, bj = p >> 5, w = p & 31, fq = w >> 3, n = (w >> 2) & 1, ii = w & 3, d = 32 * bj + 16 * n + 4 * fq + ii;
              KC[i] = (bf16_t)f2bf(A->in[I_CK][(i & ~63) + d]); }
            { const int t = i & 255, d = (i >> 8) & 63, hv = (i >> 14) & 1, b = i >> 15;
              VCT[(b * 2 + hv) * 16384 + (t >> 4) * 1024 + d * 16 + (t & 15)] = (bf16_t)f2bf(A->in[I_CV][((size_t)(b * 256 + t) * 2 + hv) * 64 + d]); }
        }
        if (bx == G - 1) {
            for (int i = tid; i < 1024; i += 512) { const int pos = i >> 4, f = i & 15;
                const float inv = __builtin_amdgcn_exp2f(-(float)f * (13.287712379549449f / 16.f)); const float ang = (float)pos * inv;
                const float rev = ang * 0.15915494309189535f; const float fr_ = rev - rintf(rev);
                ROPE[i] = __builtin_amdgcn_cosf(fr_); ROPE[1024 + i] = __builtin_amdgcn_sinf(fr_); }
        }
        for (int it = bx; it < 192; it += G) {
            const int l = it / 96, n0 = (it % 96) * 32;
            LAS float* s = (LAS float*)lds;
            for (int i = tid; i < 5120; i += 512) { const int ci = i >> 10, k = i & 1023; const float x = ci == 0 ? A->in[I_CCTX][k] : A->in[I_C][(ci - 1) * 1024 + k]; s[i] = silu_f(x); }
            __syncthreads();
            gemv_block(lds, l == 0 ? A->in[I_ADAWE] : A->in[I_ADAWO], 3072, n0, l == 0 ? A->in[I_ADABE] : A->in[I_ADABO], ADA + l * 15360, 3072);
        }
        {
            LAS float* scr = (LAS float*)(lds + wave * 16384);
            const int gw = bx * 8 + wave, NGW = G * 8;
            constexpr int I_E = 16 * (NE / 32);
            const bool late = (G == 256);
            constexpr int I_OE = 16 * 32, I_IO = 16 * (NO / 32), I_P = 4 * 32, I_OO = 16 * 32, NIT = I_E + I_OE + I_IO + I_P + I_OO;
            for (int it = gw; it < (late ? I_E : NIT); it += NGW) {
                int r = it;
                if (r < I_E) { transpose_item<true>(A->in[I_WINE], 1024, NE, WE, 0, scr, r, lane); continue; } r -= I_E;
                if (r < I_OE) { transpose_item<false>(A->in[I_WOUTE], 1024, 1024, WOE, 0, scr, r, lane); continue; } r -= I_OE;
                if (r < I_IO) { transpose_item<false>(A->in[I_WINO], 1024, NO, WIO, 0, scr, r, lane); continue; } r -= I_IO;
                if (r < I_P) { const int g4 = r >> 5; transpose_item<false>(A->in[I_POOLW] + (size_t)g4 * 65536, 256, 256, PW, g4 * 256, scr, r & 31, lane); continue; } r -= I_P;
                transpose_item<false>(A->in[I_WOUTO], 1024, 1024, WOO, 0, scr, r, lane);
            }
        }
        __syncthreads();
    }
    }
    SEAM(0);
    for (int rep_ = 0, nrep_ = (PROBE_PH == 1 ? 1 + ap->pad : 1); rep_ < nrep_; ++rep_) { if (rep_) xcd_barrier(xbar);
    if (IN(1)) {
        KArgs A = opaque_args(ap); TIDS;
        float* ADA = WSP(float, WS_ADA); float* SB = WSP(float, WS_SB); bf16_t* H0 = WSP(bf16_t, WS_H0);

        for (int it = bx; it < (G == 256 ? 0 : 64); it += G) {
            LAS float* s = (LAS float*)lds;
            for (int i = tid; i < 5120; i += 512) { const int ci = i >> 10, k = i & 1023; s[i] = ADA[15360 + ci * 3072 + k]; }
            __syncthreads();
            gemv_block(lds, A->in[I_WINO], NO, it * 32, nullptr, SB, NO);
        }
        const int gw = bx * 8 + wave, NGW = G * 8;
        for (int r = gw; r < MROWS; r += 2 * NGW) {
            const int r2 = r + NGW < MROWS ? r + NGW : r;
            const float* xa = r < MCTX ? A->in[I_XP] + (size_t)r * DM : A->in[I_XS] + (size_t)(r - MCTX) * DM;
            const float* xb = r2 < MCTX ? A->in[I_XP] + (size_t)r2 * DM : A->in[I_XS] + (size_t)(r2 - MCTX) * DM;
            f32x4 va[4], vb[4]; float sa = 0.f, sb2 = 0.f;
#pragma unroll
            for (int j = 0; j < 4; ++j) { va[j] = __builtin_nontemporal_load((const f32x4*)(xa + 4 * lane + 256 * j)); vb[j] = __builtin_nontemporal_load((const f32x4*)(xb + 4 * lane + 256 * j)); }
#pragma unroll
            for (int j = 0; j < 4; ++j) { sa += (va[j][0] * va[j][0] + va[j][1] * va[j][1]) + (va[j][2] * va[j][2] + va[j][3] * va[j][3]);
                                          sb2 += (vb[j][0] * vb[j][0] + vb[j][1] * vb[j][1]) + (vb[j][2] * vb[j][2] + vb[j][3] * vb[j][3]); }
#pragma unroll
            for (int o = 1; o < 64; o <<= 1) { sa += __shfl_xor(sa, o); sb2 += __shfl_xor(sb2, o); }
            const float rsa = __builtin_amdgcn_rsqf(sa * (1.f / 1024.f) + EPSN), rsb = __builtin_amdgcn_rsqf(sb2 * (1.f / 1024.f) + EPSN);
            const int cia = cond_of_row(r), cib = cond_of_row(r2);
#pragma unroll
            for (int j = 0; j < 4; ++j) { const int k = 4 * lane + 256 * j;
                const f32x4 g = *(const f32x4*)(A->in[I_NGE] + k);
                { const f32x4 sh = *(const f32x4*)(ADA + cia * 3072 + k), sc = *(const f32x4*)(ADA + cia * 3072 + 1024 + k);
                  const f32x4 h = va[j] * rsa * g * (sc + 1.0f) + sh; u32x2 w; w.x = cvt_pk_bf16(h[0], h[1]); w.y = cvt_pk_bf16(h[2], h[3]);
                  *(u32x2*)(H0 + (size_t)r * DM + k) = w; }
                { const f32x4 sh = *(const f32x4*)(ADA + cib * 3072 + k), sc = *(const f32x4*)(ADA + cib * 3072 + 1024 + k);
                  const f32x4 h = vb[j] * rsb * g * (sc + 1.0f) + sh; u32x2 w; w.x = cvt_pk_bf16(h[0], h[1]); w.y = cvt_pk_bf16(h[2], h[3]);
                  *(u32x2*)(H0 + (size_t)r2 * DM + k) = w; }
            }
        }
    }
    }
    SEAM(1);
    for (int rep_ = 0, nrep_ = (PROBE_PH == 2 ? 1 + ap->pad : 1); rep_ < nrep_; ++rep_) { if (rep_) xcd_barrier(xbar);
    if (IN(2)) {
        KArgs A = opaque_args(ap); TIDS;
        float* outk = A->out + (size_t)MROWS * DM; float* outv = outk + 524288; float* ROPE = WSP(float, WS_ROPE);

        pg8::Gemm g{WSP(bf16_t, WS_H0), WSP(bf16_t, WS_WE), MROWS, NE, 1024, 1024, 1024, 0}; pg8::StaticOrder S; S.init(MROWS, NE, G, bx);
        EpiE E{WSP(bf16_t, WS_U0), WSP(bf16_t, WS_BGA), WSP(bf16_t, WS_Q), WSP(bf16_t, WS_K), WSP(bf16_t, WS_VT), WSP(bf16_t, WS_VT + 1 * MiB), WSP(bf16_t, WS_SG), outk, outv, A->in[I_QG], A->in[I_KG], ROPE, ROPE + 1024};
        pg8::gemm_phase<EpiE, true>(lds, g, S, E);
        if (G == 256 && bx >= 112) {
            bf16_t* WOE = WSP(bf16_t, WS_WOE); bf16_t* WIO = WSP(bf16_t, WS_WIO); bf16_t* PW = WSP(bf16_t, WS_PW); bf16_t* WOO = WSP(bf16_t, WS_WOO);
            LAS float* scr = (LAS float*)(lds + wave * 16384);
            constexpr int I_OE = 16 * 32, I_IO = 16 * (NO / 32), I_P = 4 * 32, I_OO = 16 * 32, NIT2 = I_OE + I_IO + I_P + I_OO;
            for (int it = (bx - 112) * 8 + wave; it < NIT2; it += 144 * 8) {
                int r = it;
                if (r < I_OE) { transpose_item<false>(A->in[I_WOUTE], 1024, 1024, WOE, 0, scr, r, lane); continue; } r -= I_OE;
                if (r < I_IO) { transpose_item<false>(A->in[I_WINO], 1024, NO, WIO, 0, scr, r, lane); continue; } r -= I_IO;
                if (r < I_P) { const int g4 = r >> 5; transpose_item<false>(A->in[I_POOLW] + (size_t)g4 * 65536, 256, 256, PW, g4 * 256, scr, r & 31, lane); continue; } r -= I_P;
                transpose_item<false>(A->in[I_WOUTO], 1024, 1024, WOO, 0, scr, r, lane);
            }
        }
    }
    }
    SEAM(2);
    for (int rep_ = 0, nrep_ = (PROBE_PH == 3 ? 1 + (ap->pad & 7) : 1); rep_ < nrep_; ++rep_) { if (rep_) xcd_barrier(xbar);
    if (IN(3)) {
        KArgs A = opaque_args(ap); TIDS;

        AttnP P{WSP(bf16_t, WS_Q), WSP(bf16_t, WS_K), WSP(bf16_t, WS_KC), WSP(bf16_t, WS_VT), WSP(bf16_t, WS_VT + 1 * MiB), WSP(bf16_t, WS_VCT), WSP(bf16_t, WS_SG), WSP(bf16_t, WS_A2), A->in[I_SINK]};
        const int vb = (G % 8 == 0) ? (bx % 8) * (G / 8) + bx / 8 : bx;
        const int part = (PROBE_PH == 3 && rep_) ? (ap->pad >> 8) & 7 : 7, pfl = (PROBE_PH == 3 && rep_) ? (ap->pad >> 8) & 24 : 0;
        if (part & 1) for (int u = vb * 8 + wave; u < 2048; u += G * 8) attn_unit(lds, P, true, u >> 9, (u >> 8) & 1, ((u >> 7) & 1) * 2, (u & 127) * 16, lane, pfl);
        if (wave < 4) { if (part & 2) for (int c = vb * 4 + wave; c < 1024; c += G * 4) attn_unit(lds, P, false, c >> 6, (c >> 5) & 1, ((c >> 4) & 1) * 2, (c & 15) * 16, lane, pfl); }
        else { if (part & 4) for (int it = vb * 4 + (wave - 4); it < 3072; it += G * 4) conv_item(WSP(bf16_t, WS_U0), WSP(bf16_t, WS_BGA), WSP(bf16_t, WS_A2), A->in[I_CONVW], A->in[I_CONVB], it, lane); }
    }
    }
    SEAM(3);
    if (IN(4)) {
        KArgs A = opaque_args(ap); TIDS;
        float* ADA = WSP(float, WS_ADA);

        pg8::Gemm g{WSP(bf16_t, WS_A2), WSP(bf16_t, WS_WOE), MROWS, 1024, 1024, 1024, 1024, 0}; pg8::StaticOrder S; S.init(MROWS, 1024, G, bx);
        EpiOut0 E{A->in[I_XP], A->in[I_XS], ADA, ADA + 15360, A->in[I_NGO], WSP(bf16_t, WS_Y1), WSP(bf16_t, WS_Y1G), WSP(float, WS_ROWSS)};
        pg8::gemm_phase<EpiOut0, true>(lds, g, S, E);
        if (G == 256 && bx >= 192) {
            float* SB = WSP(float, WS_SB);
            LAS float* s = (LAS float*)lds;
            for (int i = tid; i < 5120; i += 512) { const int ci = i >> 10, k = i & 1023; s[i] = ADA[15360 + ci * 3072 + k]; }
            __syncthreads();
            gemv_block(lds, A->in[I_WINO], NO, (bx - 192) * 32, nullptr, SB, NO);
        }
    }
    SEAM(4);
    for (int rep_ = 0, nrep_ = (PROBE_PH == 5 ? 1 + ap->pad : 1); rep_ < nrep_; ++rep_) { if (rep_) xcd_barrier(xbar);
    if (IN(5)) {
        KArgs A = opaque_args(ap); TIDS;

        pg8::Gemm g{WSP(bf16_t, WS_Y1G), WSP(bf16_t, WS_WIO), MROWS, NO, 1024, 1024, 1024, 0}; pg8::StaticOrder S; S.init(MROWS, NO, G, bx);
        EpiOdd E{WSP(float, WS_ROWSS), WSP(float, WS_SB), WSP(bf16_t, WS_U1), WSP(bf16_t, WS_SG2)};
        pg8::gemm_phase<EpiOdd, true>(lds, g, S, E);
    }
    }
    SEAM(5);
    for (int rep_ = 0, nrep_ = (PROBE_PH == 6 ? 1 + ap->pad : 1); rep_ < nrep_; ++rep_) { if (rep_) xcd_barrier(xbar);
    if (IN(6)) {
        KArgs A = opaque_args(ap); TIDS;

        if (G < 192) for (int it = bx * 8 + wave; it < 6144; it += G * 8) pool_item(WSP(bf16_t, WS_U1), WSP(bf16_t, WS_POOLED), it, lane);
    }
    }
    if (G < 192) SEAM(6);
    for (int rep_ = 0, nrep_ = (PROBE_PH == 7 ? 1 + ap->pad : 1); rep_ < nrep_; ++rep_) { if (rep_) xcd_barrier(xbar);
    if (IN(7)) {
        KArgs A = opaque_args(ap); TIDS;

        pg8::Gemm g{WSP(bf16_t, WS_POOLED), WSP(bf16_t, WS_PW), MROWS, 1024, 256, 1024, 256, 512}; pg8::StaticOrder S; S.init(MROWS, 1024, G, bx);
        if (G >= 192) {
            pg8::Unit u0;
            if (S.next(0, u0)) {
                for (int j = wave; j < 32; j += 8) pool_item(WSP(bf16_t, WS_U1), WSP(bf16_t, WS_POOLED), (u0.pm * 32 + j) * 4 + u0.pn, lane, true);
            }
            asm volatile("s_waitcnt vmcnt(0)" ::: "memory");
            __syncthreads();
        }
        EpiPool E{A->in[I_PSCALE], WSP(bf16_t, WS_SG2), WSP(bf16_t, WS_A4)};
        pg8::gemm_phase<EpiPool, true>(lds, g, S, E);
    }
    }
    SEAM(7);
    for (int rep_ = 0, nrep_ = (PROBE_PH == 8 ? 1 + ap->pad : 1); rep_ < nrep_; ++rep_) { if (rep_) xcd_barrier(xbar);
    if (IN(8)) {
        KArgs A = opaque_args(ap); TIDS;

        pg8::Gemm g{WSP(bf16_t, WS_A4), WSP(bf16_t, WS_WOO), MROWS, 1024, 1024, 1024, 1024, 0}; pg8::StaticOrder S; S.init(MROWS, 1024, G, bx);
        EpiFinal E{WSP(bf16_t, WS_Y1), WSP(float, WS_ADA) + 15360, A->out};
        pg8::gemm_phase<EpiFinal, true>(lds, g, S, E);
    }
    }
    if (ap->coop == 1) {
        if (threadIdx.x == 0) bst[2] = (__hip_atomic_fetch_add(&g_bar[XB_DONE], 1u, __ATOMIC_RELAXED, __HIP_MEMORY_SCOPE_AGENT) == (unsigned)(G - 1)) ? 1u : 0u;
        __syncthreads();
        if (bst[2]) {
            const int t = threadIdx.x;
            if (t < 16) { g_bar[XB_XCNT(t)] = 0u; g_bar[XB_XSUB(t)] = 0u; g_bar[XB_XGEN(t)] = 0u; }
            if (t == 16) { g_bar[XB_TOP] = 0u; g_bar[XB_TOPGEN] = 0u; g_bar[XB_TMO] = 0u; g_bar[XB_DONE] = 0u; }
        }
    }
#ifdef PROBE_SYNC
    for (int q_ = 0; q_ < 8; ++q_) xcd_barrier(xbar);
#endif
#undef IN
#undef SEAM
}

extern "C" void kernel_launch(void* const* d_in, const int* in_sizes, int n_in, void* d_out, int out_size, void* d_ws, size_t ws_size, hipStream_t stream) {
    static int grid = 0;
    if (grid == 0) {
        int dev = 0, cus = 0, per_cu = 0;
        hipGetDevice(&dev);
        hipDeviceGetAttribute(&cus, hipDeviceAttributeMultiprocessorCount, dev);
        if (hipFuncSetAttribute((const void*)mk_fwd, hipFuncAttributeMaxDynamicSharedMemorySize, LDS_BYTES) != hipSuccess) fprintf(stderr, "kernel_launch: hipFuncSetAttribute failed\n");
        if (hipOccupancyMaxActiveBlocksPerMultiprocessor(&per_cu, (const void*)mk_fwd, 512, LDS_BYTES) != hipSuccess || per_cu < 1) { fprintf(stderr, "kernel_launch: occupancy query gave %d\n", per_cu); per_cu = 1; }
        (void)hipGetLastError();
        grid = cus * per_cu; if (grid > 256) grid = 256;
        if (n_in != 23 || ws_size < WS_END) { fprintf(stderr, "kernel_launch: unexpected n_in %d / ws %zu\n", n_in, ws_size); }
    }
    Args a{};
    for (int i = 0; i < 23; ++i) a.in[i] = (const float*)d_in[i];
    a.out = (float*)d_out; a.ws = (unsigned char*)d_ws;
#if MK_MULTI
    for (int ph = 0; ph < 9; ++ph) { a.ph_lo = ph; a.ph_hi = ph + 1; a.coop = 0; hipLaunchKernelGGL(mk_fwd, dim3(grid), dim3(512), LDS_BYTES, stream, a); }
#else
    for (int ph = 0; ph <= PROBE_PREFIX; ++ph) { a.ph_lo = ph; a.ph_hi = ph + 1; a.coop = 0; hipLaunchKernelGGL(mk_fwd, dim3(grid), dim3(512), LDS_BYTES, stream, a); }
    a.ph_lo = 0; a.ph_hi = 9; a.coop = 1; a.pad = PROBE_REPS;
    void* args[] = {&a};
    hipError_t e = hipLaunchCooperativeKernel((const void*)mk_fwd, dim3(grid), dim3(512), args, LDS_BYTES, stream);
    if (e != hipSuccess) fprintf(stderr, "cooperative launch failed: %s (grid %d)\n", hipGetErrorString(e), grid);
#endif
}
```

```cpp
#include <hip/hip_runtime.h>
#include <hip/hip_cooperative_groups.h>
#include <cstdio>
#include <cstdint>
namespace cg = cooperative_groups;

#ifndef MK_MULTI
#define MK_MULTI 0
#endif
#ifndef PROBE_REPS
#define PROBE_REPS 0
#endif
#ifndef PROBE_PH
#define PROBE_PH -1
#endif
#ifndef PROBE_PREFIX
#define PROBE_PREFIX -1
#endif

#define LAS __attribute__((address_space(3)))
typedef unsigned short bf16_t;
typedef short bf16x8 __attribute__((ext_vector_type(8)));
typedef float f32x4 __attribute__((ext_vector_type(4)));
typedef unsigned u32x4 __attribute__((ext_vector_type(4)));
typedef unsigned u32x2 __attribute__((ext_vector_type(2)));

constexpr int MROWS = 12288, MCTX = 4096, DM = 1024, NE = 3328, NO = 2048;
constexpr float EPSN = 1e-6f, LOG2E = 1.4426950408889634f;
constexpr size_t MiB = 1u << 20;
constexpr size_t WS_ADA = 0, WS_SB = 131072, WS_ROPE = 196608, WS_ROWSS = 262144, WS_BAR = 327680, WS_KC = 524288, WS_VCT = 786432;
constexpr size_t WS_WE = 1 * MiB, WS_WOE = 8 * MiB, WS_WIO = 10 * MiB, WS_PW = 14 * MiB, WS_WOO = 15 * MiB;
constexpr size_t WS_H0 = 18 * MiB, WS_U0 = 42 * MiB, WS_BGA = 54 * MiB, WS_Q = 66 * MiB, WS_K = 78 * MiB, WS_VT = 81 * MiB, WS_SG = 84 * MiB;
constexpr size_t WS_A2 = 96 * MiB, WS_Y1 = 120 * MiB, WS_END = 168 * MiB;
constexpr size_t WS_Y1G = WS_H0, WS_POOLED = WS_H0, WS_U1 = WS_A2, WS_SG2 = WS_U0, WS_A4 = WS_A2;
constexpr int LDS_BYTES = 131072 + 1024;

__device__ __forceinline__ unsigned cvt_pk_bf16(float lo, float hi) { unsigned r; asm volatile("v_cvt_pk_bf16_f32 %0, %1, %2" : "=v"(r) : "v"(lo), "v"(hi)); return r; }
__device__ __forceinline__ float bf_lo(unsigned w) { return __uint_as_float(w << 16); }
__device__ __forceinline__ float bf_hi(unsigned w) { return __uint_as_float(w & 0xffff0000u); }
__device__ __forceinline__ float silu_f(float x) { return x * __builtin_amdgcn_rcpf(1.f + __expf(-x)); }
typedef unsigned u32x2p __attribute__((ext_vector_type(2)));
__device__ __forceinline__ float rowmax4(float x) {
    unsigned xi = __float_as_uint(x); u32x2p r = __builtin_amdgcn_permlane32_swap(xi, xi, false, false);
    const float m = fmaxf(__uint_as_float(r.x), __uint_as_float(r.y)); xi = __float_as_uint(m);
    r = __builtin_amdgcn_permlane16_swap(xi, xi, false, false); return fmaxf(__uint_as_float(r.x), __uint_as_float(r.y));
}
__device__ __forceinline__ float rowsum4(float x) {
    unsigned xi = __float_as_uint(x); u32x2p r = __builtin_amdgcn_permlane32_swap(xi, xi, false, false);
    const float m = __uint_as_float(r.x) + __uint_as_float(r.y); xi = __float_as_uint(m);
    r = __builtin_amdgcn_permlane16_swap(xi, xi, false, false); return __uint_as_float(r.x) + __uint_as_float(r.y);
}
__device__ __forceinline__ void own2line(f32x4& a, f32x4& b) {
#pragma unroll
    for (int i = 0; i < 4; ++i) { unsigned x = __float_as_uint(a[i]), y = __float_as_uint(b[i]);
        u32x2p r = __builtin_amdgcn_permlane16_swap(x, y, false, false); r = __builtin_amdgcn_permlane32_swap(r.x, r.y, false, false);
        a[i] = __uint_as_float(r.x); b[i] = __uint_as_float(r.y); }
}
__device__ __forceinline__ void line2own(f32x4& a, f32x4& b) {
#pragma unroll
    for (int i = 0; i < 4; ++i) { unsigned x = __float_as_uint(a[i]), y = __float_as_uint(b[i]);
        u32x2p r = __builtin_amdgcn_permlane32_swap(x, y, false, false); r = __builtin_amdgcn_permlane16_swap(r.x, r.y, false, false);
        a[i] = __uint_as_float(r.x); b[i] = __uint_as_float(r.y); }
}
__device__ __forceinline__ int cond_of_row(int r) { return r < MCTX ? 0 : 1 + ((r - MCTX) >> 11); }

namespace pg8 {
constexpr int BM = 256, BK = 64, HALF = 128, HTB = HALF * BK * 2, STAGE_BYTES = 8 * HTB, NXCD = 8, WGM = 8;
__device__ __forceinline__ int lds_byte(int r, int c) { const int st = (r >> 4) * 2 + (c >> 5), rr = r & 15, cc = c & 31, ob = rr * 64 + cc * 2; return st * 1024 + (ob ^ (((ob >> 9) & 1) << 5)); }
__device__ __forceinline__ void stage_rc(int b, int& R, int& C) { const int st = b / 1024, sb = b % 1024, swz = sb ^ (((sb >> 9) & 1) << 5); R = (st >> 1) * 16 + swz / 64; C = (st & 1) * 32 + (swz % 64) / 2; }
__device__ __forceinline__ int perm32(int rho) { const int n = rho >> 4, i = rho & 15; return 8 * (i >> 2) + 4 * n + (i & 3); }
struct Unit { int pm, pn; };
struct Gemm { const bf16_t* A; const bf16_t* Bt; int M, N, K, lda, ldb, a_pn_off; };
struct StaticOrder {
    int nM, nN, nwg, G, c;
    __device__ void init(int M, int N, int G_, int c_) { nM = M / BM; nN = N / BM; nwg = nM * nN; G = G_; c = c_; }
    __device__ bool next(int i, Unit& u) const {
        const long L = (long)i * G + c; if (L >= nwg) return false;
        int wgid = (int)L; { const int q = nwg / NXCD, r = nwg % NXCD, xcd = wgid % NXCD, off = wgid / NXCD; wgid = (xcd < r ? xcd * (q + 1) : r * (q + 1) + (xcd - r) * q) + off; }
        const int nig = WGM * nN, gid = wgid / nig, fm = gid * WGM, gsz = (nM - fm) < WGM ? (nM - fm) : WGM;
        u.pm = fm + ((wgid % nig) % gsz); u.pn = (wgid % nig) / gsz; return true;
    }
};
template <class Epi, bool ALIGN_EPI>
__device__ __forceinline__ void gemm_phase(LAS unsigned char* lds, const Gemm g, const StaticOrder& S, const Epi& E) {
    const int tid = threadIdx.x, wid = __builtin_amdgcn_readfirstlane(tid >> 6), lane = tid & 63, wr = wid >> 2, wc = wid & 3, fr = lane & 15, fq = lane >> 4;
    const int K = g.K, nt = K / BK;
    unsigned voffA[2], voffB[2];
#pragma unroll
    for (int i = 0; i < 2; ++i) { int R, C; stage_rc(tid * 16 + i * 8192, R, C); const int Rb = Epi::PERM ? ((R & ~31) + perm32(R & 31)) : R;
        voffA[i] = (unsigned)(R * g.lda + C) * 2u; voffB[i] = (unsigned)(Rb * g.ldb + C) * 2u; }
    const size_t kstep = (size_t)(BK * 2);
    const size_t hstepA = (size_t)HALF * g.lda * 2, hstepB = (size_t)HALF * g.ldb * 2;
    const size_t tstepA = 2 * hstepA, tstepB = 2 * hstepB;
    const unsigned ldsw = (unsigned)wid * 1024u;
    const int aoff = lds_byte(wr * 64 + fr, fq * 8), boff = lds_byte(wc * 32 + fr, fq * 8);
#define PG8_SA(b, h) (((b) * 2 + (h)) * HTB)
#define PG8_SB(b, h) ((4 + (b) * 2 + (h)) * HTB)
#define PG8_STAGE(bufoff, gbase, voff) do { _Pragma("unroll") for (int _i = 0; _i < 2; ++_i) \
        __builtin_amdgcn_global_load_lds((const unsigned*)((const char*)(gbase) + (voff)[_i]), (LAS unsigned*)(lds + (bufoff) + ldsw + _i * 8192), 16, 0, 0); } while (0)
#define PG8_LDA(dst, b, h) do { _Pragma("unroll") for (int m = 0; m < 4; ++m) _Pragma("unroll") for (int k = 0; k < 2; ++k) dst[m][k] = *(const LAS bf16x8*)(lds + PG8_SA(b, h) + aoff + m * 2048 + k * 1024); } while (0)
#define PG8_LDB(dst, b, h) do { _Pragma("unroll") for (int n = 0; n < 2; ++n) _Pragma("unroll") for (int k = 0; k < 2; ++k) dst[n][k] = *(const LAS bf16x8*)(lds + PG8_SB(b, h) + boff + n * 2048 + k * 1024); } while (0)
#define PG8_MMA(ai, bj, At, Bt) do { __builtin_amdgcn_s_setprio(1); _Pragma("unroll") for (int m = 0; m < 4; ++m) _Pragma("unroll") for (int n = 0; n < 2; ++n) _Pragma("unroll") for (int k = 0; k < 2; ++k) \
        acc[ai][bj][m][n] = __builtin_amdgcn_mfma_f32_16x16x32_bf16(Bt[n][k], At[m][k], acc[ai][bj][m][n], 0, 0, 0); __builtin_amdgcn_s_setprio(0); } while (0)
#define PG8_WAIT_V(n) asm volatile("s_waitcnt vmcnt(" #n ")" ::: "memory")
#define PG8_WAIT_L(n) asm volatile("s_waitcnt lgkmcnt(" #n ")" ::: "memory")
#define PG8_BAR __builtin_amdgcn_s_barrier()
#define PG8_SCHED __builtin_amdgcn_sched_barrier(0)
    Unit cur, nxt; int ui = 0;
    if (!S.next(0, cur)) return;
    f32x4 acc[2][2][4][2];
#pragma unroll
    for (int a = 0; a < 2; ++a)
#pragma unroll
        for (int b = 0; b < 2; ++b)
#pragma unroll
            for (int m = 0; m < 4; ++m)
#pragma unroll
                for (int n = 0; n < 2; ++n) acc[a][b][m][n] = (f32x4){0.f, 0.f, 0.f, 0.f};
    bf16x8 At[4][2], B0[2][2], B1[2][2];
    const char* cA = (const char*)g.A + (size_t)cur.pm * tstepA + (size_t)cur.pn * g.a_pn_off; const char* cB = (const char*)g.Bt + (size_t)cur.pn * tstepB;
    PG8_STAGE(PG8_SB(0, 0), cB, voffB); PG8_STAGE(PG8_SB(0, 1), cB + hstepB, voffB); PG8_STAGE(PG8_SA(0, 0), cA, voffA); PG8_STAGE(PG8_SA(0, 1), cA + hstepA, voffA);
    if (wr == 1) PG8_BAR;
    PG8_WAIT_V(2); PG8_BAR;
    PG8_STAGE(PG8_SB(1, 0), cB + kstep, voffB); PG8_STAGE(PG8_SA(1, 0), cA + kstep, voffA); PG8_STAGE(PG8_SB(1, 1), cB + hstepB + kstep, voffB);
    PG8_WAIT_V(6); PG8_BAR;
    for (;;) {
        const bool has_next = S.next(ui + 1, nxt);
        const char* nA = has_next ? (const char*)g.A + (size_t)nxt.pm * tstepA + (size_t)nxt.pn * g.a_pn_off : cA; const char* nB = has_next ? (const char*)g.Bt + (size_t)nxt.pn * tstepB : cB;
#pragma nounroll
        for (int t = 0; t < nt; t += 2) {
            const bool last = (t == nt - 2);
            const char* a1 = cA + (size_t)(t + 1) * kstep;
            const char* a2 = last ? nA : cA + (size_t)(t + 2) * kstep; const char* b2 = last ? nB : cB + (size_t)(t + 2) * kstep;
            const char* a3 = a2 + kstep; const char* b3 = b2 + kstep;
            PG8_LDB(B0, 0, 0); PG8_LDB(B1, 0, 1); PG8_SCHED; PG8_LDA(At, 0, 0); PG8_STAGE(PG8_SA(1, 1), a1 + hstepA, voffA);
            PG8_WAIT_V(8); PG8_WAIT_L(0); PG8_BAR; PG8_MMA(0, 0, At, B0); PG8_MMA(0, 1, At, B1); PG8_BAR; PG8_SCHED;
            PG8_LDA(At, 0, 1); PG8_STAGE(PG8_SB(0, 0), b2, voffB); PG8_STAGE(PG8_SB(0, 1), b2 + hstepB, voffB); PG8_STAGE(PG8_SA(0, 0), a2, voffA);
            PG8_WAIT_V(8); PG8_WAIT_L(0); PG8_BAR; PG8_MMA(1, 0, At, B0); PG8_MMA(1, 1, At, B1); PG8_BAR; PG8_SCHED;
            PG8_LDB(B0, 1, 0); PG8_LDB(B1, 1, 1); PG8_SCHED; PG8_LDA(At, 1, 0); PG8_STAGE(PG8_SA(0, 1), a2 + hstepA, voffA);
            PG8_WAIT_V(8); PG8_WAIT_L(0); PG8_BAR; PG8_MMA(0, 0, At, B0); PG8_MMA(0, 1, At, B1); PG8_BAR; PG8_SCHED;
            PG8_LDA(At, 1, 1); PG8_STAGE(PG8_SB(1, 0), b3, voffB); PG8_STAGE(PG8_SB(1, 1), b3 + hstepB, voffB); PG8_STAGE(PG8_SA(1, 0), a3, voffA);
            PG8_WAIT_V(8); PG8_WAIT_L(0); PG8_BAR; PG8_MMA(1, 0, At, B0); PG8_MMA(1, 1, At, B1); PG8_BAR; PG8_SCHED;
        }
        if constexpr (ALIGN_EPI) { if (wr == 0) PG8_BAR; }
        E(acc, cur, wr, wc, fr, fq);
        if (!has_next) break;
#pragma unroll
        for (int a = 0; a < 2; ++a)
#pragma unroll
            for (int b = 0; b < 2; ++b)
#pragma unroll
                for (int m = 0; m < 4; ++m)
#pragma unroll
                    for (int n = 0; n < 2; ++n) acc[a][b][m][n] = (f32x4){0.f, 0.f, 0.f, 0.f};
        cur = nxt; cA = nA; cB = nB; ++ui;
        if constexpr (ALIGN_EPI) { if (wr == 1) PG8_BAR; }
    }
    PG8_WAIT_V(0);
    if constexpr (!ALIGN_EPI) { if (wr == 0) PG8_BAR; }
    PG8_BAR;
#undef PG8_SA
#undef PG8_SB
#undef PG8_STAGE
#undef PG8_LDA
#undef PG8_LDB
#undef PG8_MMA
#undef PG8_WAIT_V
#undef PG8_WAIT_L
#undef PG8_BAR
#undef PG8_SCHED
}
}

typedef f32x4 Acc[2][2][4][2];

struct EpiE {
    static constexpr bool PERM = true;
    bf16_t *U0, *BGA, *Q, *Kb, *VtC, *VtL, *SG; float *outk, *outv; const float *qg, *kg, *ropeC, *ropeS;
    __device__ __forceinline__ void operator()(const Acc& acc, const pg8::Unit& u, int wr, int wc, int fr, int fq) const {
        asm volatile("" : "+v"(fr), "+v"(fq));
        const int pn = u.pn, row0 = u.pm * 256 + wr * 64 + fr;
        if (pn < 8) {
            bf16_t* dst = (pn < 4 ? U0 : BGA) + (pn & 3) * 128 + wc * 32 + 8 * fq;
#pragma unroll
            for (int ai = 0; ai < 2; ++ai)
#pragma unroll
                for (int m = 0; m < 4; ++m) {
                    const int r = row0 + ai * 128 + m * 16;
                    f32x4 a0 = acc[ai][0][m][0], a1 = acc[ai][0][m][1], b0 = acc[ai][1][m][0], b1 = acc[ai][1][m][1];
                    if (pn >= 4) {
#pragma unroll
                        for (int i = 0; i < 4; ++i) { b0[i] = silu_f(b0[i]); b1[i] = silu_f(b1[i]); }
                    }
                    a0 = a0 * b0; a1 = a1 * b1;
                    u32x4 w; w.x = cvt_pk_bf16(a0[0], a0[1]); w.y = cvt_pk_bf16(a0[2], a0[3]); w.z = cvt_pk_bf16(a1[0], a1[1]); w.w = cvt_pk_bf16(a1[2], a1[3]);
                    *(u32x4*)(dst + (size_t)r * 512) = w;
                }
        } else if (pn < 10 || (pn == 10 && wc < 2)) {
            const bool isq = pn < 10, latent = u.pm >= 16;
            const int head = isq ? 4 * (pn - 8) + wc : wc;
            const float* gam = isq ? qg : kg;
            const float osc = isq ? 0.125f * LOG2E : 1.0f;
#pragma unroll
            for (int ai = 0; ai < 2; ++ai)
#pragma unroll
                for (int m = 0; m < 4; ++m) {
                    const int r = row0 + ai * 128 + m * 16;
                    f32x4 v[2][2]; float ss = 0.f;
#pragma unroll
                    for (int bj = 0; bj < 2; ++bj)
#pragma unroll
                        for (int n = 0; n < 2; ++n) { v[bj][n] = acc[ai][bj][m][n]; ss += (v[bj][n][0] * v[bj][n][0] + v[bj][n][1] * v[bj][n][1]) + (v[bj][n][2] * v[bj][n][2] + v[bj][n][3] * v[bj][n][3]); }
                    ss = rowsum4(ss);
                    const float rs = __builtin_amdgcn_rsqf(ss * (1.f / 64.f) + EPSN);
#pragma unroll
                    for (int bj = 0; bj < 2; ++bj)
#pragma unroll
                        for (int n = 0; n < 2; ++n) v[bj][n] = v[bj][n] * rs * (*(const f32x4*)(gam + 32 * bj + 16 * n + 4 * fq));
                    if (latent) {
                        const int t = (r - MCTX) & 2047;
#pragma unroll
                        for (int bj = 0; bj < 2; ++bj) {
                            const int pos = bj == 0 ? (t >> 6) : (t & 63);
                            const f32x4 cs = *(const f32x4*)(ropeC + pos * 16 + 4 * fq), sn = *(const f32x4*)(ropeS + pos * 16 + 4 * fq);
                            const f32x4 x1 = v[bj][0], x2 = v[bj][1];
                            v[bj][0] = x1 * cs - x2 * sn; v[bj][1] = x2 * cs + x1 * sn;
                        }
                    } else if (!isq) {
                        float* ok = outk + ((size_t)r * 2 + head) * 64 + 4 * fq;
#pragma unroll
                        for (int bj = 0; bj < 2; ++bj)
#pragma unroll
                            for (int n = 0; n < 2; ++n) *(f32x4*)(ok + 32 * bj + 16 * n) = v[bj][n];
                    }
                    bf16_t* dst = isq ? Q + (size_t)r * 512 + head * 64 : Kb + (size_t)r * 128 + head * 64;
#pragma unroll
                    for (int bj = 0; bj < 2; ++bj) {
                        const f32x4 a0 = v[bj][0] * osc, a1 = v[bj][1] * osc;
                        u32x4 w; w.x = cvt_pk_bf16(a0[0], a0[1]); w.y = cvt_pk_bf16(a0[2], a0[3]); w.z = cvt_pk_bf16(a1[0], a1[1]); w.w = cvt_pk_bf16(a1[2], a1[3]);
                        *(u32x4*)(dst + 32 * bj + 8 * fq) = w;
                    }
                    asm volatile("" ::: "memory");
                }
        } else if (pn == 10) {
            const int hv = wc - 2; const bool latent = u.pm >= 16;
#pragma unroll
            for (int ai = 0; ai < 2; ++ai)
#pragma unroll
                for (int m = 0; m < 4; ++m) {
                    const int r = row0 + ai * 128 + m * 16;
                    bf16_t* vt; int L;
                    if (latent) { const int b = (r - MCTX) >> 11, t = (r - MCTX) & 2047; vt = VtL + (size_t)(b * 2 + hv) * 64 * 2048 + (t >> 4) * 1024 + (t & 15); }
                    else { const int b = r >> 8, t = r & 255; vt = VtC + (size_t)(b * 2 + hv) * 64 * 256 + (t >> 4) * 1024 + (t & 15); }
                    L = 16;
#pragma unroll
                    for (int bj = 0; bj < 2; ++bj)
#pragma unroll
                        for (int n = 0; n < 2; ++n) {
                            const f32x4 x = acc[ai][bj][m][n]; const int d0 = 32 * bj + 8 * fq + 4 * n;
                            if (!latent) *(f32x4*)(outv + ((size_t)r * 2 + hv) * 64 + d0) = x;
                            const unsigned p0 = cvt_pk_bf16(x[0], x[1]), p1 = cvt_pk_bf16(x[2], x[3]);
                            vt[(size_t)(d0 + 0) * L] = (bf16_t)(p0 & 0xffffu); vt[(size_t)(d0 + 1) * L] = (bf16_t)(p0 >> 16);
                            vt[(size_t)(d0 + 2) * L] = (bf16_t)(p1 & 0xffffu); vt[(size_t)(d0 + 3) * L] = (bf16_t)(p1 >> 16);
                        }
                    asm volatile("" ::: "memory");
                }
        } else {
            bf16_t* dst = SG + (pn - 11) * 256 + wc * 32 + 8 * fq;
#pragma unroll
            for (int ai = 0; ai < 2; ++ai)
#pragma unroll
                for (int m = 0; m < 4; ++m) {
                    const int r = row0 + ai * 128 + m * 16;
#pragma unroll
                    for (int bj = 0; bj < 2; ++bj) {
                        f32x4 a0 = acc[ai][bj][m][0], a1 = acc[ai][bj][m][1];
#pragma unroll
                        for (int i = 0; i < 4; ++i) { a0[i] = silu_f(a0[i]); a1[i] = silu_f(a1[i]); }
                        u32x4 w; w.x = cvt_pk_bf16(a0[0], a0[1]); w.y = cvt_pk_bf16(a0[2], a0[3]); w.z = cvt_pk_bf16(a1[0], a1[1]); w.w = cvt_pk_bf16(a1[2], a1[3]);
                        *(u32x4*)(dst + (size_t)r * 512 + bj * 128) = w;
                    }
                }
        }
    }
};

struct EpiOut0 {
    static constexpr bool PERM = true;
    const float *xp, *xs, *ada0, *ada1, *g1; bf16_t* Y1; bf16_t* Y1G; float* rowss;
    __device__ __forceinline__ void operator()(const Acc& acc, const pg8::Unit& u, int wr, int wc, int fr, int fq) const {
        asm volatile("" : "+v"(fr), "+v"(fq));
        const int ci = u.pm < 16 ? 0 : 1 + ((u.pm - 16) >> 3);
        const int col0 = u.pn * 256 + wc * 32 + 8 * fq;
        f32x4 gate[2][2], gm[2][2];
#pragma unroll
        for (int bj = 0; bj < 2; ++bj)
#pragma unroll
            for (int n = 0; n < 2; ++n) { const int col = col0 + bj * 128 + n * 4;
                gate[bj][n] = *(const f32x4*)(ada0 + ci * 3072 + 2048 + col);
                gm[bj][n] = *(const f32x4*)(g1 + col) * (*(const f32x4*)(ada1 + ci * 3072 + 1024 + col) + 1.0f); }
#pragma unroll
        for (int ai = 0; ai < 2; ++ai)
#pragma unroll
            for (int m = 0; m < 4; ++m) {
                const int r = u.pm * 256 + ai * 128 + wr * 64 + m * 16 + fr;
                const float* xrow = r < MCTX ? xp + (size_t)r * DM : xs + (size_t)(r - MCTX) * DM;
                float ss = 0.f;
#pragma unroll
                for (int bj = 0; bj < 2; ++bj) { const int col = col0 + bj * 128;
                    f32x4 xa = __builtin_nontemporal_load((const f32x4*)(xrow + col - 4 * fq)), xb = __builtin_nontemporal_load((const f32x4*)(xrow + col - 4 * fq + 16));
                    line2own(xa, xb);
                    const f32x4 y0 = xa + gate[bj][0] * acc[ai][bj][m][0];
                    const f32x4 y1 = xb + gate[bj][1] * acc[ai][bj][m][1];
                    ss += ((y0[0] * y0[0] + y0[1] * y0[1]) + (y0[2] * y0[2] + y0[3] * y0[3])) + ((y1[0] * y1[0] + y1[1] * y1[1]) + (y1[2] * y1[2] + y1[3] * y1[3]));
                    u32x4 wy; wy.x = cvt_pk_bf16(y0[0], y0[1]); wy.y = cvt_pk_bf16(y0[2], y0[3]); wy.z = cvt_pk_bf16(y1[0], y1[1]); wy.w = cvt_pk_bf16(y1[2], y1[3]);
                    *(u32x4*)(Y1 + (size_t)r * DM + col) = wy;
                    const f32x4 g0 = y0 * gm[bj][0], g1v = y1 * gm[bj][1];
                    u32x4 w; w.x = cvt_pk_bf16(g0[0], g0[1]); w.y = cvt_pk_bf16(g0[2], g0[3]); w.z = cvt_pk_bf16(g1v[0], g1v[1]); w.w = cvt_pk_bf16(g1v[2], g1v[3]);
                    *(u32x4*)(Y1G + (size_t)r * DM + col) = w; }
                ss = rowsum4(ss);
                if (fq == 0) atomicAdd(rowss + r, ss);
                asm volatile("" ::: "memory");
            }
    }
};

struct EpiOdd {
    static constexpr bool PERM = true;
    const float *rowss, *sb; bf16_t *U1, *SG2;
    __device__ __forceinline__ void operator()(const Acc& acc, const pg8::Unit& u, int wr, int wc, int fr, int fq) const {
        asm volatile("" : "+v"(fr), "+v"(fq));
        const int ci = u.pm < 16 ? 0 : 1 + ((u.pm - 16) >> 3);
        const int col0 = u.pn * 256 + wc * 32 + 8 * fq;
        f32x4 sbv[2][2];
#pragma unroll
        for (int bj = 0; bj < 2; ++bj)
#pragma unroll
            for (int n = 0; n < 2; ++n) sbv[bj][n] = *(const f32x4*)(sb + ci * NO + col0 + bj * 128 + 4 * n);
        const bool isg = u.pn >= 4;
        bf16_t* dst = isg ? SG2 + (col0 - 1024) : U1 + col0;
#pragma unroll
        for (int ai = 0; ai < 2; ++ai)
#pragma unroll
            for (int m = 0; m < 4; ++m) {
                const int r = u.pm * 256 + ai * 128 + wr * 64 + m * 16 + fr;
                const float rstd = __builtin_amdgcn_rsqf(rowss[r] * (1.f / 1024.f) + EPSN);
#pragma unroll
                for (int bj = 0; bj < 2; ++bj) {
                    f32x4 a0 = acc[ai][bj][m][0] * rstd + sbv[bj][0], a1 = acc[ai][bj][m][1] * rstd + sbv[bj][1];
                    if (isg) {
#pragma unroll
                        for (int i = 0; i < 4; ++i) { a0[i] = silu_f(a0[i]); a1[i] = silu_f(a1[i]); }
                    }
                    u32x4 w; w.x = cvt_pk_bf16(a0[0], a0[1]); w.y = cvt_pk_bf16(a0[2], a0[3]); w.z = cvt_pk_bf16(a1[0], a1[1]); w.w = cvt_pk_bf16(a1[2], a1[3]);
                    *(u32x4*)(dst + (size_t)r * DM + bj * 128) = w;
                }
            }
    }
};

struct EpiPool {
    static constexpr bool PERM = true;
    const float* pscale; const bf16_t* SG2; bf16_t* A4;
    __device__ __forceinline__ void operator()(const Acc& acc, const pg8::Unit& u, int wr, int wc, int fr, int fq) const {
        asm volatile("" : "+v"(fr), "+v"(fq));
        const int col0 = u.pn * 256 + wc * 32 + 8 * fq;
        f32x4 ps[2][2];
#pragma unroll
        for (int bj = 0; bj < 2; ++bj)
#pragma unroll
            for (int n = 0; n < 2; ++n) ps[bj][n] = *(const f32x4*)(pscale + col0 + bj * 128 + 4 * n);
#pragma unroll
        for (int ai = 0; ai < 2; ++ai)
#pragma unroll
            for (int m = 0; m < 4; ++m) {
                const int r = u.pm * 256 + ai * 128 + wr * 64 + m * 16 + fr;
#pragma unroll
                for (int bj = 0; bj < 2; ++bj) {
                    const u32x4 sg = *(const u32x4*)(SG2 + (size_t)r * DM + col0 + bj * 128);
                    f32x4 a0 = acc[ai][bj][m][0] * ps[bj][0], a1 = acc[ai][bj][m][1] * ps[bj][1];
                    a0[0] *= bf_lo(sg.x); a0[1] *= bf_hi(sg.x); a0[2] *= bf_lo(sg.y); a0[3] *= bf_hi(sg.y);
                    a1[0] *= bf_lo(sg.z); a1[1] *= bf_hi(sg.z); a1[2] *= bf_lo(sg.w); a1[3] *= bf_hi(sg.w);
                    u32x4 w; w.x = cvt_pk_bf16(a0[0], a0[1]); w.y = cvt_pk_bf16(a0[2], a0[3]); w.z = cvt_pk_bf16(a1[0], a1[1]); w.w = cvt_pk_bf16(a1[2], a1[3]);
                    *(u32x4*)(A4 + (size_t)r * DM + col0 + bj * 128) = w;
                }
                asm volatile("" ::: "memory");
            }
    }
};

struct EpiFinal {
    static constexpr bool PERM = true;
    const bf16_t* Y1; const float* ada1; float* out;
    __device__ __forceinline__ void operator()(const Acc& acc, const pg8::Unit& u, int wr, int wc, int fr, int fq) const {
        asm volatile("" : "+v"(fr), "+v"(fq));
        const int ci = u.pm < 16 ? 0 : 1 + ((u.pm - 16) >> 3);
        const int col0 = u.pn * 256 + wc * 32 + 8 * fq;
        f32x4 gate[2][2];
#pragma unroll
        for (int bj = 0; bj < 2; ++bj)
#pragma unroll
            for (int n = 0; n < 2; ++n) gate[bj][n] = *(const f32x4*)(ada1 + ci * 3072 + 2048 + col0 + bj * 128 + n * 4);
#pragma unroll
        for (int ai = 0; ai < 2; ++ai)
#pragma unroll
            for (int m = 0; m < 4; ++m) {
                const size_t ro = (size_t)(u.pm * 256 + ai * 128 + wr * 64 + m * 16 + fr) * DM;
#pragma unroll
                for (int bj = 0; bj < 2; ++bj) { const int col = col0 + bj * 128;
                    const u32x4 yb = *(const u32x4*)(Y1 + ro + col);
                    const f32x4 ya = {bf_lo(yb.x), bf_hi(yb.x), bf_lo(yb.y), bf_hi(yb.y)}, yc = {bf_lo(yb.z), bf_hi(yb.z), bf_lo(yb.w), bf_hi(yb.w)};
                    f32x4 oa = ya + gate[bj][0] * acc[ai][bj][m][0], ob = yc + gate[bj][1] * acc[ai][bj][m][1];
                    own2line(oa, ob);
                    __builtin_nontemporal_store(oa, (f32x4*)(out + ro + col - 4 * fq));
                    __builtin_nontemporal_store(ob, (f32x4*)(out + ro + col - 4 * fq + 16)); }
                if (m & 1) asm volatile("" ::: "memory");
            }
    }
};

__device__ __forceinline__ int colmap_e(int np) {
    const int pn = np >> 8, c = np & 255, bj = c >> 7, wc = (c >> 5) & 3, w = c & 31;
    if (pn < 4) return (bj ? 1024 : 512) + pn * 128 + (c & 127);
    if (pn < 8) return (bj ? 1536 : 0) + (pn - 4) * 128 + (c & 127);
    const int fq = w >> 3, n = (w >> 2) & 1, i = w & 3, d = 32 * bj + 16 * n + 4 * fq + i;
    if (pn < 10) return 2048 + (4 * (pn - 8) + wc) * 64 + d;
    if (pn == 10) { if (wc < 2) return 2560 + wc * 64 + d; return 2688 + (wc - 2) * 64 + 32 * bj + w; }
    return 2816 + (pn - 11) * 256 + c;
}
__device__ __forceinline__ unsigned f2bf(float f) { unsigned u = __float_as_uint(f); return (u + 0x7fffu + ((u >> 16) & 1u)) >> 16; }
__device__ __forceinline__ unsigned pk2(float lo, float hi) { return f2bf(lo) | (f2bf(hi) << 16); }
template <bool PERME>
__device__ __forceinline__ void transpose_item(const float* W, int K, int N, bf16_t* WT, int row_off, LAS float* scr, int item, int lane) {
    const int nblk = N / 32, kb = item / nblk, nb = item % nblk, k0 = 64 * kb, n0 = 32 * nb;
    const int srcc = PERME ? colmap_e(n0 + (lane & 31)) : n0 + (lane & 31);
#pragma unroll 8
    for (int i = 0; i < 32; ++i) { const int kk = 2 * i + (lane >> 5); scr[kk * 33 + (lane & 31)] = __builtin_nontemporal_load(W + (size_t)(k0 + kk) * N + srcc); }
    asm volatile("s_waitcnt lgkmcnt(0)" ::: "memory");
    const int c = lane & 7;
#pragma unroll
    for (int j = 0; j < 4; ++j) { const int n = (lane >> 3) + 8 * j; const LAS float* s = scr + (8 * c) * 33 + n;
        u32x4 o; o.x = pk2(s[0 * 33], s[1 * 33]); o.y = pk2(s[2 * 33], s[3 * 33]); o.z = pk2(s[4 * 33], s[5 * 33]); o.w = pk2(s[6 * 33], s[7 * 33]);
        *(u32x4*)(WT + (size_t)(row_off + n0 + n) * K + k0 + 8 * c) = o; }
    asm volatile("s_waitcnt lgkmcnt(0)" ::: "memory");
}
__device__ __forceinline__ void gemv_block(LAS unsigned char* lds, const float* W, int N, int n0, const float* bias, float* out, int out_stride) {
    LAS float* s = (LAS float*)lds; LAS float* red = (LAS float*)(lds + 20480);
    const int tid = threadIdx.x, col = tid & 31, ks = tid >> 5;
    float a[5] = {0.f, 0.f, 0.f, 0.f, 0.f};
    const float* wp = W + (size_t)(ks * 64) * N + n0 + col;
#pragma unroll 16
    for (int k = 0; k < 64; ++k) { const float w = __builtin_nontemporal_load(wp + (size_t)k * N);
#pragma unroll
        for (int ci = 0; ci < 5; ++ci) a[ci] += s[ci * 1024 + ks * 64 + k] * w; }
#pragma unroll
    for (int ci = 0; ci < 5; ++ci) red[(ks * 5 + ci) * 32 + col] = a[ci];
    __syncthreads();
    if (tid < 160) { const int ci = tid >> 5; float t = bias ? bias[n0 + col] : 0.f;
#pragma unroll
        for (int k2 = 0; k2 < 16; ++k2) t += red[(k2 * 5 + ci) * 32 + col];
        out[ci * out_stride + n0 + col] = t; }
    __syncthreads();
}

struct AttnP { const bf16_t *Q, *K, *KC, *VtC, *VtL, *VCt, *SG; bf16_t* A2; const float* sink; };
constexpr int NH = 2;
#define MFMA16(a, b, c) __builtin_amdgcn_mfma_f32_16x16x32_bf16((a), (b), (c), 0, 0, 0)
__device__ __forceinline__ void attn_loadk(bf16x8 (&kf)[2][2], const bf16_t* kb, int k0, int Lk, int c16, int kq) {
#pragma unroll
    for (int kt = 0; kt < 2; ++kt) { int key = k0 + 8 * (c16 >> 2) + 4 * kt + (c16 & 3); key = key < 0 ? 0 : (key > Lk - 1 ? Lk - 1 : key);
#pragma unroll
        for (int ks = 0; ks < 2; ++ks) kf[kt][ks] = *(const bf16x8*)(kb + (size_t)key * 128 + 32 * ks + 8 * kq); }
}
__device__ __forceinline__ void attn_loadv(bf16x8 (&vf)[4], const bf16_t* vb, int k0, int Lk, int c16, int kq) {
    int tok = k0 + 8 * kq; tok = tok < 0 ? 0 : (tok > Lk - 8 ? Lk - 8 : tok);
#pragma unroll
    for (int dt = 0; dt < 4; ++dt) vf[dt] = *(const bf16x8*)(vb + (size_t)(tok >> 4) * 1024 + (16 * dt + c16) * 16 + (tok & 15));
}

__device__ __forceinline__ void rowpair(unsigned& m0, unsigned& m1) {
    u32x2p r = __builtin_amdgcn_permlane32_swap(m0, m1, false, false); m0 = r.x; m1 = r.y;
    r = __builtin_amdgcn_permlane16_swap(m0, m1, false, false); m0 = r.x; m1 = r.y;
}
__device__ __forceinline__ void attn_mask(f32x4& s0, f32x4& s1, int mode, int k0, int Lk, int tq, int kq) {
#pragma unroll
    for (int j = 0; j < 4; ++j) { const int ka = k0 + 8 * kq + j, kb2 = ka + 4; const int da = tq - ka, db = tq - kb2;
        const bool va = mode == 1 && ka >= 0 && ka < Lk && da <= 128 && da >= -128, vb2 = mode == 1 && kb2 >= 0 && kb2 < Lk && db <= 128 && db >= -128;
        s0[j] = va ? s0[j] : -1e30f; s1[j] = vb2 ? s1[j] : -1e30f; }
}
__device__ __forceinline__ void attn_compute(f32x4 (&o)[NH][4], float (&m2)[NH], float (&l)[NH], const bf16x8 (&qf)[NH][2],
                                             const bf16x8 (&kfA)[2][2], const bf16x8 (&vfA)[4], const bf16x8 (&kfB)[2][2], const bf16x8 (&vfB)[4],
                                             int modeA, int k0A, int LkA, int modeB, int k0B, int LkB, int tq, int kq) {
#pragma unroll
    for (int hq = 0; hq < NH; ++hq) {
        const f32x4 z = {0.f, 0.f, 0.f, 0.f};
        f32x4 a0 = MFMA16(kfA[0][0], qf[hq][0], z); a0 = MFMA16(kfA[0][1], qf[hq][1], a0);
        f32x4 a1 = MFMA16(kfA[1][0], qf[hq][0], z); a1 = MFMA16(kfA[1][1], qf[hq][1], a1);
        f32x4 b0 = MFMA16(kfB[0][0], qf[hq][0], z); b0 = MFMA16(kfB[0][1], qf[hq][1], b0);
        f32x4 b1 = MFMA16(kfB[1][0], qf[hq][0], z); b1 = MFMA16(kfB[1][1], qf[hq][1], b1);
        if (modeA) attn_mask(a0, a1, modeA, k0A, LkA, tq, kq);
        if (modeB) attn_mask(b0, b1, modeB, k0B, LkB, tq, kq);
        float mx = fmaxf(fmaxf(fmaxf(fmaxf(a0[0], a0[1]), fmaxf(a0[2], a0[3])), fmaxf(fmaxf(a1[0], a1[1]), fmaxf(a1[2], a1[3]))),
                         fmaxf(fmaxf(fmaxf(b0[0], b0[1]), fmaxf(b0[2], b0[3])), fmaxf(fmaxf(b1[0], b1[1]), fmaxf(b1[2], b1[3]))));
        mx = rowmax4(mx);
        if (__builtin_amdgcn_ballot_w64(mx > m2[hq] + 8.0f) != 0ull) {
            const float mn = fmaxf(m2[hq], mx), alpha = __builtin_amdgcn_exp2f(m2[hq] - mn); m2[hq] = mn; l[hq] *= alpha;
#pragma unroll
            for (int dt = 0; dt < 4; ++dt) o[hq][dt] = o[hq][dt] * alpha;
        }
        const float mr = m2[hq];
        float ps = 0.f;
#pragma unroll
        for (int j = 0; j < 4; ++j) { a0[j] = __builtin_amdgcn_exp2f(a0[j] - mr); a1[j] = __builtin_amdgcn_exp2f(a1[j] - mr); b0[j] = __builtin_amdgcn_exp2f(b0[j] - mr); b1[j] = __builtin_amdgcn_exp2f(b1[j] - mr); }
        ps = ((a0[0] + a0[1]) + (a0[2] + a0[3])) + ((a1[0] + a1[1]) + (a1[2] + a1[3])) + (((b0[0] + b0[1]) + (b0[2] + b0[3])) + ((b1[0] + b1[1]) + (b1[2] + b1[3])));
        l[hq] += ps;
        u32x4 pa, pb; pa.x = cvt_pk_bf16(a0[0], a0[1]); pa.y = cvt_pk_bf16(a0[2], a0[3]); pa.z = cvt_pk_bf16(a1[0], a1[1]); pa.w = cvt_pk_bf16(a1[2], a1[3]);
        pb.x = cvt_pk_bf16(b0[0], b0[1]); pb.y = cvt_pk_bf16(b0[2], b0[3]); pb.z = cvt_pk_bf16(b1[0], b1[1]); pb.w = cvt_pk_bf16(b1[2], b1[3]);
        const bf16x8 pfa = __builtin_bit_cast(bf16x8, pa), pfb = __builtin_bit_cast(bf16x8, pb);
#pragma unroll
        for (int dt = 0; dt < 4; ++dt) { o[hq][dt] = MFMA16(vfA[dt], pfa, o[hq][dt]); o[hq][dt] = MFMA16(vfB[dt], pfb, o[hq][dt]); }
    }
}

__device__ __forceinline__ void attn_unit(LAS unsigned char* lds, const AttnP& P, bool latent, int b, int kvh, int hq0, int q0, int lane, int pflags = 0) {
    const int c16 = lane & 15, kq = lane >> 4;
    const int L = latent ? 2048 : 256;
    const int rowbase = latent ? MCTX + b * 2048 : b * 256;
    const int qrow = rowbase + q0 + c16, tq = q0 + c16;
    bf16x8 qf[NH][2];
#pragma unroll
    for (int hq = 0; hq < NH; ++hq)
#pragma unroll
        for (int ks = 0; ks < 2; ++ks) qf[hq][ks] = *(const bf16x8*)(P.Q + (size_t)qrow * 512 + (4 * kvh + hq0 + hq) * 64 + 32 * ks + 8 * kq);
    u32x2 sgv[NH][4];
#pragma unroll
    for (int hq = 0; hq < NH; ++hq)
#pragma unroll
        for (int dt = 0; dt < 4; ++dt) sgv[hq][dt] = *(const u32x2*)(P.SG + (size_t)qrow * 512 + (4 * kvh + hq0 + hq) * 64 + 16 * dt + 4 * kq);
    f32x4 o[NH][4]; float m2[NH], l[NH];
#pragma unroll
    for (int hq = 0; hq < NH; ++hq) { m2[hq] = P.sink[4 * kvh + hq0 + hq] * LOG2E; l[hq] = kq == 0 ? 1.f : 0.f;
#pragma unroll
        for (int dt = 0; dt < 4; ++dt) o[hq][dt] = (f32x4){0.f, 0.f, 0.f, 0.f}; }
    const bf16_t* Kl = P.K + (size_t)rowbase * 128 + kvh * 64;
    const bf16_t* Vl = latent ? P.VtL + (size_t)(b * 2 + kvh) * 64 * 2048 : P.VtC + (size_t)(b * 2 + kvh) * 64 * 256;
    const bf16_t* Kc = P.KC + (size_t)b * 256 * 128 + kvh * 64;
    const bf16_t* Vc = P.VCt + (size_t)(b * 2 + kvh) * 64 * 256;
    int kloc0, nloc, nh;
    if (latent) { int st_lo = (128 - q0) / 32; if (st_lo < 0 || q0 > 128) st_lo = 0; int st_hi = (2176 - q0 + 31) / 32; if (st_hi > 9) st_hi = 9;
        kloc0 = q0 - 128 + 32 * st_lo; nloc = st_hi - st_lo; nh = nloc + 8; }
    else { kloc0 = 0; nloc = 8; nh = 8; }
    const int nsteps = (nh + 1) >> 1;
#define HSRC(h, kb_, vb_, k0_, Lk_, md_) const int hh_##k0_ = (h) < nh ? (h) : nh - 1; const bool lc_##k0_ = hh_##k0_ < nloc; \
        const bf16_t* kb_ = lc_##k0_ ? Kl : Kc; const bf16_t* vb_ = lc_##k0_ ? Vl : Vc; const int k0_ = lc_##k0_ ? kloc0 + 32 * hh_##k0_ : 32 * (hh_##k0_ - nloc); const int Lk_ = lc_##k0_ ? L : 256; \
        const int md_ = (h) >= nh ? 2 : ((latent && lc_##k0_ && (k0_ < 0 || k0_ + 32 > L || k0_ < q0 - 112 || k0_ + 31 > q0 + 128)) ? 1 : 0)
    bf16x8 kfA[2][2], kfB[2][2], knA[2][2], knB[2][2];
    { HSRC(0, kbA_, vbA_, k0A_, LkA_, mdA_); HSRC(1, kbB_, vbB_, k0B_, LkB_, mdB_); (void)vbA_; (void)vbB_; (void)mdA_; (void)mdB_;
      attn_loadk(kfA, kbA_, k0A_, LkA_, c16, kq); attn_loadk(kfB, kbB_, k0B_, LkB_, c16, kq); }
    for (int st = 0; st < nsteps; ++st) {
        bf16x8 vfA[4], vfB[4];
        HSRC(2 * st, kbA, vbA, k0A, LkA, mdA); HSRC(2 * st + 1, kbB, vbB, k0B, LkB, mdB); (void)kbA; (void)kbB;
        attn_loadv(vfA, vbA, k0A, LkA, c16, kq); attn_loadv(vfB, vbB, k0B, LkB, c16, kq);
        { HSRC(2 * st + 2, kbC, vbC, k0C, LkC, mdC); HSRC(2 * st + 3, kbD, vbD, k0D, LkD, mdD); (void)vbC; (void)vbD; (void)mdC; (void)mdD;
          attn_loadk(knA, kbC, k0C, LkC, c16, kq); attn_loadk(knB, kbD, k0D, LkD, c16, kq); }
        __builtin_amdgcn_sched_barrier(0);
        attn_compute(o, m2, l, qf, kfA, vfA, kfB, vfB, mdA, k0A, LkA, mdB, k0B, LkB, tq, kq);
#pragma unroll
        for (int kt = 0; kt < 2; ++kt) { kfA[kt][0] = knA[kt][0]; kfA[kt][1] = knA[kt][1]; kfB[kt][0] = knB[kt][0]; kfB[kt][1] = knB[kt][1]; }
    }
#undef HSRC
#pragma unroll
    for (int hq = 0; hq < NH; ++hq) {
        const float lt = rowsum4(l[hq]);
        const float inv = 1.f / lt;
        unsigned wx[4], wy[4];
#pragma unroll
        for (int dt = 0; dt < 4; ++dt) {
            const u32x2 sg = sgv[hq][dt];
            const f32x4 v = o[hq][dt] * inv;
            wx[dt] = cvt_pk_bf16(v[0] * bf_lo(sg.x), v[1] * bf_hi(sg.x)); wy[dt] = cvt_pk_bf16(v[2] * bf_lo(sg.y), v[3] * bf_hi(sg.y));
        }
        rowpair(wx[0], wx[1]); rowpair(wy[0], wy[1]); rowpair(wx[2], wx[3]); rowpair(wy[2], wy[3]);
        bf16_t* dst = P.A2 + (size_t)qrow * DM + 512 + (4 * kvh + hq0 + hq) * 64 + 8 * kq;
        if (!(pflags & 8)) { *(u32x4*)dst = (u32x4){wx[0], wy[0], wx[1], wy[1]}; *(u32x4*)(dst + 32) = (u32x4){wx[2], wy[2], wx[3], wy[3]}; }
    }
}

__device__ __forceinline__ void load8(const bf16_t* p, float (&v)[8]) { const u32x4 w = *(const u32x4*)p; v[0] = bf_lo(w.x); v[1] = bf_hi(w.x); v[2] = bf_lo(w.y); v[3] = bf_hi(w.y); v[4] = bf_lo(w.z); v[5] = bf_hi(w.z); v[6] = bf_lo(w.w); v[7] = bf_hi(w.w); }
__device__ __forceinline__ void unpack8(const u32x4 w, float (&v)[8]) { v[0] = bf_lo(w.x); v[1] = bf_hi(w.x); v[2] = bf_lo(w.y); v[3] = bf_hi(w.y); v[4] = bf_lo(w.z); v[5] = bf_hi(w.z); v[6] = bf_lo(w.w); v[7] = bf_hi(w.w); }
__device__ __forceinline__ void store8(bf16_t* p, const float (&v)[8]) { u32x4 w; w.x = cvt_pk_bf16(v[0], v[1]); w.y = cvt_pk_bf16(v[2], v[3]); w.z = cvt_pk_bf16(v[4], v[5]); w.w = cvt_pk_bf16(v[6], v[7]); *(u32x4*)p = w; }
__device__ __forceinline__ void conv_item(const bf16_t* U0, const bf16_t* BGA, bf16_t* A2, const float* cw, const float* cb, int item, int lane) {
    const int c = 8 * lane, r0 = 4 * item;
    const int t0 = r0 < MCTX ? (r0 & 255) : ((r0 - MCTX) & 2047), L = r0 < MCTX ? 256 : 2048;
    u32x4 ur[6], gr[4];
#pragma unroll
    for (int i = 0; i < 6; ++i) { const int t = t0 - 1 + i; const int rr = r0 - 1 + i + (t < 0 ? 1 : 0) - (t >= L ? 1 : 0); ur[i] = *(const u32x4*)(U0 + (size_t)rr * 512 + c); if (t < 0 || t >= L) ur[i] = (u32x4){0u, 0u, 0u, 0u}; }
#pragma unroll
    for (int i = 0; i < 4; ++i) gr[i] = *(const u32x4*)(BGA + (size_t)(r0 + i) * 512 + c);
    float w0[8], w1[8], w2[8], bb[8];
#pragma unroll
    for (int i = 0; i < 8; ++i) { w0[i] = cw[c + i]; w1[i] = cw[512 + c + i]; w2[i] = cw[1024 + c + i]; bb[i] = cb[c + i]; }
#pragma unroll
    for (int i = 0; i < 4; ++i) {
        float pv[8], cu[8], nx[8], g[8], y[8];
        unpack8(ur[i], pv); unpack8(ur[i + 1], cu); unpack8(ur[i + 2], nx); unpack8(gr[i], g);
#pragma unroll
        for (int k = 0; k < 8; ++k) y[k] = g[k] * (w0[k] * pv[k] + w1[k] * cu[k] + w2[k] * nx[k] + bb[k]);
        store8(A2 + (size_t)(r0 + i) * DM + c, y);
    }
}

template <int H>
__device__ __forceinline__ void pool_item_t(const bf16_t* U1, bf16_t* PO, int gi, int chunk, int lane) {
    constexpr int R = 4, NR = R - 1 + 2 * H;
    const int hw = lane >> 5, c = gi * 256 + 8 * (lane & 31), r0 = chunk * (2 * R) + R * hw;
    const int rs = r0 < MCTX ? (r0 & ~255) : MCTX + ((r0 - MCTX) & ~2047), L = r0 < MCTX ? 256 : 2048, t0 = r0 - rs;
    const bf16_t* base = U1 + (size_t)rs * DM + c;
    u32x4 raw[NR];
#pragma unroll
    for (int i = 0; i < NR; ++i) { const int t = t0 - H + i; const int tc = t < 0 ? 0 : (t > L - 1 ? L - 1 : t); raw[i] = *(const u32x4*)(base + (size_t)tc * DM); if (t < 0 || t >= L) raw[i] = (u32x4){0u, 0u, 0u, 0u}; }
    float S[8];
#pragma unroll
    for (int k = 0; k < 8; ++k) S[k] = 0.f;
#pragma unroll
    for (int i = 0; i < 2 * H; ++i) { float v[8]; unpack8(raw[i], v);
#pragma unroll
        for (int k = 0; k < 8; ++k) S[k] += v[k]; }
#pragma unroll
    for (int tt = 0; tt < R; ++tt) {
        const int t = t0 + tt, lo = t - H > 0 ? t - H : 0, hi = t + H < L ? t + H : L;
        const float rc = 1.f / (float)(hi - lo);
        float uc[8], y[8]; unpack8(raw[tt + H], uc);
#pragma unroll
        for (int k = 0; k < 8; ++k) y[k] = S[k] * rc - uc[k];
        store8(PO + (size_t)(rs + t) * DM + c, y);
        if (tt < R - 1) { float va[8], vs[8]; unpack8(raw[tt + 2 * H], va); unpack8(raw[tt], vs);
#pragma unroll
            for (int k = 0; k < 8; ++k) S[k] += va[k] - vs[k]; }
    }
}
__device__ __forceinline__ void pool_item(const bf16_t* U1, bf16_t* PO, int item, int lane, bool direct = false) {
    const int chunk = item >> 2, gi = direct ? (item & 3) : ((item + (item >> 11)) & 3);
    if (gi == 0) pool_item_t<1>(U1, PO, 0, chunk, lane);
    else if (gi == 1) pool_item_t<2>(U1, PO, 1, chunk, lane);
    else if (gi == 2) pool_item_t<4>(U1, PO, 2, chunk, lane);
    else pool_item_t<8>(U1, PO, 3, chunk, lane);
}


#define XB_TMO      128
#define XB_XCNT(j)  (256  + 64 * (j))
#define XB_XSUB(j)  (1280 + 64 * (j))
#define XB_XGEN(j)  (2304 + 64 * (j))
#define XB_TOP      3328
#define XB_TOPGEN   3392
#define XCD_BAR_WORDS 3456
#define XB_SPIN_CAP (1u << 18)
__device__ __forceinline__ unsigned xb_ld(unsigned* p)              { return __hip_atomic_load(p, __ATOMIC_RELAXED, __HIP_MEMORY_SCOPE_AGENT); }
__device__ __forceinline__ unsigned xb_add(unsigned* p, unsigned v) { return __hip_atomic_fetch_add(p, v, __ATOMIC_RELAXED, __HIP_MEMORY_SCOPE_AGENT); }
__device__ __forceinline__ unsigned xb_xcc_id() { return (unsigned)__builtin_amdgcn_s_getreg((3 << 11) | 20) & 0xFu; }
#define XB_SPIN(cond, bar) do { unsigned _sp = 0; while (cond) { __builtin_amdgcn_s_sleep(1); \
    if ((++_sp & 255u) == 0u) { if (xb_ld(&(bar)[XB_TMO])) break; if (_sp > XB_SPIN_CAP) { atomicAdd(&(bar)[XB_TMO], 1u); break; } } } } while (0)
struct XcdBarrier { unsigned* bar; unsigned x; volatile LAS unsigned* st; };
#define XB_DONE 3520
__device__ unsigned g_bar[4096];
__device__ __forceinline__ XcdBarrier xcd_barrier_post(unsigned* bar, volatile LAS unsigned* st) {
    XcdBarrier b; b.bar = bar; b.x = xb_xcc_id(); b.st = st;
    if (threadIdx.x == 0) (void)xb_add(&bar[XB_XCNT(b.x)], 1u);
    return b;
}
__device__ __forceinline__ void xcd_barrier_complete(unsigned* bar, unsigned x, unsigned& nloc, unsigned& nx) {
    const unsigned G = gridDim.x * gridDim.y * gridDim.z;
    unsigned sum, cnt, mine, sp = 0u;
    for (;;) {
        sum = 0u; cnt = 0u; mine = 0u;
#pragma unroll
        for (unsigned j = 0; j < 16; ++j) { const unsigned c = xb_ld(&bar[XB_XCNT(j)]); sum += c; cnt += (c > 0u) ? 1u : 0u; mine = (j == x) ? c : mine; }
        if (sum == G) break;
        __builtin_amdgcn_s_sleep(1);
        if ((++sp & 255u) == 0u) { if (xb_ld(&bar[XB_TMO])) break; if (sp > XB_SPIN_CAP) { atomicAdd(&bar[XB_TMO], 1u); break; } }
    }
    nloc = mine > 0u ? mine : 1u; nx = cnt > 0u ? cnt : 1u;
}
__device__ __forceinline__ void xcd_barrier(const XcdBarrier& b) {
    asm volatile("s_waitcnt vmcnt(0)" ::: "memory");
    __syncthreads();
    if (threadIdx.x == 0) {
        unsigned* bar = b.bar;
        __builtin_amdgcn_s_waitcnt(0);
        unsigned nloc = b.st[0], nx = b.st[1];
        if (nloc == 0u) { xcd_barrier_complete(bar, b.x, nloc, nx); b.st[0] = nloc; b.st[1] = nx; }
        const unsigned old = xb_add(&bar[XB_XSUB(b.x)], 1u);
        const unsigned gen = old / nloc;
        if (old + 1u == (gen + 1u) * nloc) {
            __builtin_amdgcn_fence(__ATOMIC_RELEASE, "agent");
            asm volatile("s_waitcnt vmcnt(0)" ::: "memory");
            const unsigned og = xb_add(&bar[XB_TOP], 1u);
            const unsigned tg = og / nx;
            if (og + 1u == (tg + 1u) * nx) xb_add(&bar[XB_TOPGEN], 1u);
            else XB_SPIN(xb_ld(&bar[XB_TOPGEN]) == tg, bar);
            __builtin_amdgcn_fence(__ATOMIC_ACQUIRE, "agent");
            xb_add(&bar[XB_XGEN(b.x)], 1u);
            asm volatile("s_waitcnt vmcnt(0)" ::: "memory");
        } else {
            XB_SPIN(xb_ld(&bar[XB_XGEN(b.x)]) == gen, bar);
            __builtin_amdgcn_fence(__ATOMIC_ACQUIRE, "agent");
            asm volatile("s_waitcnt vmcnt(0)" ::: "memory");
        }
    }
    __syncthreads();
}

__device__ __forceinline__ void warm_lines(const void* p, size_t bytes, int t, int nt, unsigned* sink) {
    const u32x4* q = (const u32x4*)p; const size_t n = bytes / 16; unsigned acc = 0u;
    size_t i = (size_t)t;
    for (; i + 7 * (size_t)nt < n; i += 8 * (size_t)nt) {
        u32x4 v[8];
#pragma unroll
        for (int k = 0; k < 8; ++k) v[k] = q[i + (size_t)k * nt];
#pragma unroll
        for (int k = 0; k < 8; ++k) acc ^= (v[k].x ^ v[k].y) ^ (v[k].z ^ v[k].w);
    }
    for (; i < n; i += (size_t)nt) { const u32x4 v = q[i]; acc ^= (v.x ^ v.y) ^ (v.z ^ v.w); }
    if (acc == 0x7fc1a2b3u && t == 0x7fffffff) *sink = acc;
}
struct Args { const float* in[23]; float* out; unsigned char* ws; int ph_lo, ph_hi, coop, pad; };
enum { I_XP = 0, I_XS, I_CK, I_CV, I_C, I_CCTX, I_ADAWE, I_ADABE, I_NGE, I_WINE, I_CONVW, I_CONVB, I_QG, I_KG, I_SINK, I_WOUTE, I_ADAWO, I_ADABO, I_NGO, I_WINO, I_POOLW, I_PSCALE, I_WOUTO };

typedef const __attribute__((address_space(4))) Args* KArgs;
__device__ __forceinline__ KArgs opaque_args(KArgs p) { asm volatile("" : "+s"(p)); return p; }
#define WSP(T, off) ((T*)(A->ws + (off)))

__global__ void __launch_bounds__(512) mk_fwd(Args a_) {
    extern __shared__ __attribute__((aligned(16))) unsigned char lds_raw[];
    LAS unsigned char* lds = (LAS unsigned char*)lds_raw;
    cg::grid_group grid = cg::this_grid();
    KArgs ap = (KArgs)__builtin_amdgcn_kernarg_segment_ptr();
    const int G = gridDim.x, bx = blockIdx.x;
    const int lo = ap->ph_lo, hi = ap->ph_hi;
#define TIDS const int tid = threadIdx.x, lane = tid & 63, wave = __builtin_amdgcn_readfirstlane(tid >> 6); (void)lane; (void)wave
#ifndef PHM
#define PHM 0x1ff
#endif
#define IN(k) (((PHM >> (k)) & 1) && lo <= (k) && (k) < hi)
    volatile LAS unsigned* bst = (volatile LAS unsigned*)(lds + 131072);
    if (threadIdx.x < 4) bst[threadIdx.x] = 0u;
    __syncthreads();
    XcdBarrier xbar; xbar.bar = g_bar; xbar.x = 0; xbar.st = bst;
    if (ap->coop == 1) xbar = xcd_barrier_post(g_bar, bst);
    if (ap->coop == 2) grid.sync();
#define SEAM(k) do { if (IN(k) && IN((k) + 1)) xcd_barrier(xbar); } while (0)

    for (int rep_ = 0, nrep_ = (PROBE_PH == 0 ? 1 + ap->pad : 1); rep_ < nrep_; ++rep_) { if (rep_) xcd_barrier(xbar);
    if (IN(0)) {
        KArgs A = opaque_args(ap); TIDS;
        float* ADA = WSP(float, WS_ADA); float* ROPE = WSP(float, WS_ROPE); float* ROWSS = WSP(float, WS_ROWSS); bf16_t* KC = WSP(bf16_t, WS_KC); bf16_t* VCT = WSP(bf16_t, WS_VCT);
        bf16_t* WE = WSP(bf16_t, WS_WE); bf16_t* WOE = WSP(bf16_t, WS_WOE); bf16_t* WIO = WSP(bf16_t, WS_WIO); bf16_t* PW = WSP(bf16_t, WS_PW); bf16_t* WOO = WSP(bf16_t, WS_WOO);

        const int gt = bx * 512 + tid, NT = G * 512;
        for (int i = gt; i < MROWS; i += NT) ROWSS[i] = 0.f;
        for (int i = gt; i < 131072; i += NT) {
            { const int p = i & 63, bj = p >> 5, w = p & 31, fq = w >> 3, n = (w >> 2) & 1, ii = w & 3, d = 32 * bj + 16 * n + 4 * fq + ii;
              KC[i] = (bf16_t)f2bf(A->in[I_CK][(i & ~63) + d]); }
            { const int t = i & 255, d = (i >> 8) & 63, hv = (i >> 14) & 1, b = i >> 15;
              VCT[(b * 2 + hv) * 16384 + (t >> 4) * 1024 + d * 16 + (t & 15)] = (bf16_t)f2bf(A->in[I_CV][((size_t)(b * 256 + t) * 2 + hv) * 64 + d]); }
        }
        if (bx == G - 1) {
            for (int i = tid; i < 1024; i += 512) { const int pos = i >> 4, f = i & 15;
                const float inv = __builtin_amdgcn_exp2f(-(float)f * (13.287712379549449f / 16.f)); const float ang = (float)pos * inv;
                const float rev = ang * 0.15915494309189535f; const float fr_ = rev - rintf(rev);
                ROPE[i] = __builtin_amdgcn_cosf(fr_); ROPE[1024 + i] = __builtin_amdgcn_sinf(fr_); }
        }
        for (int it = bx; it < 192; it += G) {
            const int l = it / 96, n0 = (it % 96) * 32;
            LAS float* s = (LAS float*)lds;
            for (int i = tid; i < 5120; i += 512) { const int ci = i >> 10, k = i & 1023; const float x = ci == 0 ? A->in[I_CCTX][k] : A->in[I_C][(ci - 1) * 1024 + k]; s[i] = silu_f(x); }
            __syncthreads();
            gemv_block(lds, l == 0 ? A->in[I_ADAWE] : A->in[I_ADAWO], 3072, n0, l == 0 ? A->in[I_ADABE] : A->in[I_ADABO], ADA + l * 15360, 3072);
        }
        {
            LAS float* scr = (LAS float*)(lds + wave * 16384);
            const int gw = bx * 8 + wave, NGW = G * 8;
            constexpr int I_E = 16 * (NE / 32);
            const bool late = (G == 256);
            constexpr int I_OE = 16 * 32, I_IO = 16 * (NO / 32), I_P = 4 * 32, I_OO = 16 * 32, NIT = I_E + I_OE + I_IO + I_P + I_OO;
            for (int it = gw; it < (late ? I_E : NIT); it += NGW) {
                int r = it;
                if (r < I_E) { transpose_item<true>(A->in[I_WINE], 1024, NE, WE, 0, scr, r, lane); continue; } r -= I_E;
                if (r < I_OE) { transpose_item<false>(A->in[I_WOUTE], 1024, 1024, WOE, 0, scr, r, lane); continue; } r -= I_OE;
                if (r < I_IO) { transpose_item<false>(A->in[I_WINO], 1024, NO, WIO, 0, scr, r, lane); continue; } r -= I_IO;
                if (r < I_P) { const int g4 = r >> 5; transpose_item<false>(A->in[I_POOLW] + (size_t)g4 * 65536, 256, 256, PW, g4 * 256, scr, r & 31, lane); continue; } r -= I_P;
                transpose_item<false>(A->in[I_WOUTO], 1024, 1024, WOO, 0, scr, r, lane);
            }
        }
        __syncthreads();
    }
    }
    SEAM(0);
    for (int rep_ = 0, nrep_ = (PROBE_PH == 1 ? 1 + ap->pad : 1); rep_ < nrep_; ++rep_) { if (rep_) xcd_barrier(xbar);
    if (IN(1)) {
        KArgs A = opaque_args(ap); TIDS;
        float* ADA = WSP(float, WS_ADA); float* SB = WSP(float, WS_SB); bf16_t* H0 = WSP(bf16_t, WS_H0);

        for (int it = bx; it < (G == 256 ? 0 : 64); it += G) {
            LAS float* s = (LAS float*)lds;
            for (int i = tid; i < 5120; i += 512) { const int ci = i >> 10, k = i & 1023; s[i] = ADA[15360 + ci * 3072 + k]; }
            __syncthreads();
            gemv_block(lds, A->in[I_WINO], NO, it * 32, nullptr, SB, NO);
        }
        const int gw = bx * 8 + wave, NGW = G * 8;
        for (int r = gw; r < MROWS; r += 2 * NGW) {
            const int r2 = r + NGW < MROWS ? r + NGW : r;
            const float* xa = r < MCTX ? A->in[I_XP] + (size_t)r * DM : A->in[I_XS] + (size_t)(r - MCTX) * DM;
            const float* xb = r2 < MCTX ? A->in[I_XP] + (size_t)r2 * DM : A->in[I_XS] + (size_t)(r2 - MCTX) * DM;
            f32x4 va[4], vb[4]; float sa = 0.f, sb2 = 0.f;
#pragma unroll
            for (int j = 0; j < 4; ++j) { va[j] = __builtin_nontemporal_load((const f32x4*)(xa + 4 * lane + 256 * j)); vb[j] = __builtin_nontemporal_load((const f32x4*)(xb + 4 * lane + 256 * j)); }
#pragma unroll
            for (int j = 0; j < 4; ++j) { sa += (va[j][0] * va[j][0] + va[j][1] * va[j][1]) + (va[j][2] * va[j][2] + va[j][3] * va[j][3]);
                                          sb2 += (vb[j][0] * vb[j][0] + vb[j][1] * vb[j][1]) + (vb[j][2] * vb[j][2] + vb[j][3] * vb[j][3]); }
#pragma unroll
            for (int o = 1; o < 64; o <<= 1) { sa += __shfl_xor(sa, o); sb2 += __shfl_xor(sb2, o); }
            const float rsa = __builtin_amdgcn_rsqf(sa * (1.f / 1024.f) + EPSN), rsb = __builtin_amdgcn_rsqf(sb2 * (1.f / 1024.f) + EPSN);
            const int cia = cond_of_row(r), cib = cond_of_row(r2);
#pragma unroll
            for (int j = 0; j < 4; ++j) { const int k = 4 * lane + 256 * j;
                const f32x4 g = *(const f32x4*)(A->in[I_NGE] + k);
                { const f32x4 sh = *(const f32x4*)(ADA + cia * 3072 + k), sc = *(const f32x4*)(ADA + cia * 3072 + 1024 + k);
                  const f32x4 h = va[j] * rsa * g * (sc + 1.0f) + sh; u32x2 w; w.x = cvt_pk_bf16(h[0], h[1]); w.y = cvt_pk_bf16(h[2], h[3]);
                  *(u32x2*)(H0 + (size_t)r * DM + k) = w; }
                { const f32x4 sh = *(const f32x4*)(ADA + cib * 3072 + k), sc = *(const f32x4*)(ADA + cib * 3072 + 1024 + k);
                  const f32x4 h = vb[j] * rsb * g * (sc + 1.0f) + sh; u32x2 w; w.x = cvt_pk_bf16(h[0], h[1]); w.y = cvt_pk_bf16(h[2], h[3]);
                  *(u32x2*)(H0 + (size_t)r2 * DM + k) = w; }
            }
        }
    }
    }
    SEAM(1);
    for (int rep_ = 0, nrep_ = (PROBE_PH == 2 ? 1 + ap->pad : 1); rep_ < nrep_; ++rep_) { if (rep_) xcd_barrier(xbar);
    if (IN(2)) {
        KArgs A = opaque_args(ap); TIDS;
        float* outk = A->out + (size_t)MROWS * DM; float* outv = outk + 524288; float* ROPE = WSP(float, WS_ROPE);

        pg8::Gemm g{WSP(bf16_t, WS_H0), WSP(bf16_t, WS_WE), MROWS, NE, 1024, 1024, 1024, 0}; pg8::StaticOrder S; S.init(MROWS, NE, G, bx);
        EpiE E{WSP(bf16_t, WS_U0), WSP(bf16_t, WS_BGA), WSP(bf16_t, WS_Q), WSP(bf16_t, WS_K), WSP(bf16_t, WS_VT), WSP(bf16_t, WS_VT + 1 * MiB), WSP(bf16_t, WS_SG), outk, outv, A->in[I_QG], A->in[I_KG], ROPE, ROPE + 1024};
        pg8::gemm_phase<EpiE, true>(lds, g, S, E);
        if (G == 256 && bx >= 112) {
            bf16_t* WOE = WSP(bf16_t, WS_WOE); bf16_t* WIO = WSP(bf16_t, WS_WIO); bf16_t* PW = WSP(bf16_t, WS_PW); bf16_t* WOO = WSP(bf16_t, WS_WOO);
            LAS float* scr = (LAS float*)(lds + wave * 16384);
            constexpr int I_OE = 16 * 32, I_IO = 16 * (NO / 32), I_P = 4 * 32, I_OO = 16 * 32, NIT2 = I_OE + I_IO + I_P + I_OO;
            for (int it = (bx - 112) * 8 + wave; it < NIT2; it += 144 * 8) {
                int r = it;
                if (r < I_OE) { transpose_item<false>(A->in[I_WOUTE], 1024, 1024, WOE, 0, scr, r, lane); continue; } r -= I_OE;
                if (r < I_IO) { transpose_item<false>(A->in[I_WINO], 1024, NO, WIO, 0, scr, r, lane); continue; } r -= I_IO;
                if (r < I_P) { const int g4 = r >> 5; transpose_item<false>(A->in[I_POOLW] + (size_t)g4 * 65536, 256, 256, PW, g4 * 256, scr, r & 31, lane); continue; } r -= I_P;
                transpose_item<false>(A->in[I_WOUTO], 1024, 1024, WOO, 0, scr, r, lane);
            }
        }
    }
    }
    SEAM(2);
    for (int rep_ = 0, nrep_ = (PROBE_PH == 3 ? 1 + (ap->pad & 7) : 1); rep_ < nrep_; ++rep_) { if (rep_) xcd_barrier(xbar);
    if (IN(3)) {
        KArgs A = opaque_args(ap); TIDS;

        AttnP P{WSP(bf16_t, WS_Q), WSP(bf16_t, WS_K), WSP(bf16_t, WS_KC), WSP(bf16_t, WS_VT), WSP(bf16_t, WS_VT + 1 * MiB), WSP(bf16_t, WS_VCT), WSP(bf16_t, WS_SG), WSP(bf16_t, WS_A2), A->in[I_SINK]};
        const int vb = (G % 8 == 0) ? (bx % 8) * (G / 8) + bx / 8 : bx;
        const int part = (PROBE_PH == 3 && rep_) ? (ap->pad >> 8) & 7 : 7, pfl = (PROBE_PH == 3 && rep_) ? (ap->pad >> 8) & 24 : 0;
        if (part & 1) for (int u = vb * 8 + wave; u < 2048; u += G * 8) attn_unit(lds, P, true, u >> 9, (u >> 8) & 1, ((u >> 7) & 1) * 2, (u & 127) * 16, lane, pfl);
        if (wave < 4) { if (part & 2) for (int c = vb * 4 + wave; c < 1024; c += G * 4) attn_unit(lds, P, false, c >> 6, (c >> 5) & 1, ((c >> 4) & 1) * 2, (c & 15) * 16, lane, pfl); }
        else { if (part & 4) for (int it = vb * 4 + (wave - 4); it < 3072; it += G * 4) conv_item(WSP(bf16_t, WS_U0), WSP(bf16_t, WS_BGA), WSP(bf16_t, WS_A2), A->in[I_CONVW], A->in[I_CONVB], it, lane); }
    }
    }
    SEAM(3);
    if (IN(4)) {
        KArgs A = opaque_args(ap); TIDS;
        float* ADA = WSP(float, WS_ADA);

        pg8::Gemm g{WSP(bf16_t, WS_A2), WSP(bf16_t, WS_WOE), MROWS, 1024, 1024, 1024, 1024, 0}; pg8::StaticOrder S; S.init(MROWS, 1024, G, bx);
        EpiOut0 E{A->in[I_XP], A->in[I_XS], ADA, ADA + 15360, A->in[I_NGO], WSP(bf16_t, WS_Y1), WSP(bf16_t, WS_Y1G), WSP(float, WS_ROWSS)};
        pg8::gemm_phase<EpiOut0, true>(lds, g, S, E);
        if (G == 256 && bx >= 192) {
            float* SB = WSP(float, WS_SB);
            LAS float* s = (LAS float*)lds;
            for (int i = tid; i < 5120; i += 512) { const int ci = i >> 10, k = i & 1023; s[i] = ADA[15360 + ci * 3072 + k]; }
            __syncthreads();
            gemv_block(lds, A->in[I_WINO], NO, (bx - 192) * 32, nullptr, SB, NO);
            const int wt = (bx - 192) * 512 + tid;
            warm_lines(A->in[I_XP], (size_t)MCTX * DM * 4, wt, 64 * 512, (unsigned*)SB + 12000);
            warm_lines(A->in[I_XS], (size_t)(MROWS - MCTX) * DM * 4, wt, 64 * 512, (unsigned*)SB + 12000);
        }
    }
    SEAM(4);
    for (int rep_ = 0, nrep_ = (PROBE_PH == 5 ? 1 + ap->pad : 1); rep_ < nrep_; ++rep_) { if (rep_) xcd_barrier(xbar);
    if (IN(5)) {
        KArgs A = opaque_args(ap); TIDS;

        pg8::Gemm g{WSP(bf16_t, WS_Y1G), WSP(bf16_t, WS_WIO), MROWS, NO, 1024, 1024, 1024, 0}; pg8::StaticOrder S; S.init(MROWS, NO, G, bx);
        EpiOdd E{WSP(float, WS_ROWSS), WSP(float, WS_SB), WSP(bf16_t, WS_U1), WSP(bf16_t, WS_SG2)};
        pg8::gemm_phase<EpiOdd, true>(lds, g, S, E);
    }
    }
    SEAM(5);
    for (int rep_ = 0, nrep_ = (PROBE_PH == 6 ? 1 + ap->pad : 1); rep_ < nrep_; ++rep_) { if (rep_) xcd_barrier(xbar);
    if (IN(6)) {
        KArgs A = opaque_args(ap); TIDS;

        if (G < 192) for (int it = bx * 8 + wave; it < 6144; it += G * 8) pool_item(WSP(bf16_t, WS_U1), WSP(bf16_t, WS_POOLED), it, lane);
    }
    }
    if (G < 192) SEAM(6);
    for (int rep_ = 0, nrep_ = (PROBE_PH == 7 ? 1 + ap->pad : 1); rep_ < nrep_; ++rep_) { if (rep_) xcd_barrier(xbar);
    if (IN(7)) {
        KArgs A = opaque_args(ap); TIDS;

        pg8::Gemm g{WSP(bf16_t, WS_POOLED), WSP(bf16_t, WS_PW), MROWS, 1024, 256, 1024, 256, 512}; pg8::StaticOrder S; S.init(MROWS, 1024, G, bx);
        if (G >= 192) {
            pg8::Unit u0;
            if (S.next(0, u0)) {
                for (int j = wave; j < 32; j += 8) pool_item(WSP(bf16_t, WS_U1), WSP(bf16_t, WS_POOLED), (u0.pm * 32 + j) * 4 + u0.pn, lane, true);
            }
            asm volatile("s_waitcnt vmcnt(0)" ::: "memory");
            __syncthreads();
        }
        EpiPool E{A->in[I_PSCALE], WSP(bf16_t, WS_SG2), WSP(bf16_t, WS_A4)};
        pg8::gemm_phase<EpiPool, true>(lds, g, S, E);
    }
    }
    SEAM(7);
    for (int rep_ = 0, nrep_ = (PROBE_PH == 8 ? 1 + ap->pad : 1); rep_ < nrep_; ++rep_) { if (rep_) xcd_barrier(xbar);
    if (IN(8)) {
        KArgs A = opaque_args(ap); TIDS;

        pg8::Gemm g{WSP(bf16_t, WS_A4), WSP(bf16_t, WS_WOO), MROWS, 1024, 1024, 1024, 1024, 0}; pg8::StaticOrder S; S.init(MROWS, 1024, G, bx);
        EpiFinal E{WSP(bf16_t, WS_Y1), WSP(float, WS_ADA) + 15360, A->out};
        pg8::gemm_phase<EpiFinal, true>(lds, g, S, E);
        if (G == 256 && bx >= 192) warm_lines(WSP(bf16_t, WS_Y1), (size_t)MROWS * DM * 2, (bx - 192) * 512 + tid, 64 * 512, (unsigned*)(A->ws + WS_SB) + 12000);
    }
    }
    if (ap->coop == 1) {
        if (threadIdx.x == 0) bst[2] = (__hip_atomic_fetch_add(&g_bar[XB_DONE], 1u, __ATOMIC_RELAXED, __HIP_MEMORY_SCOPE_AGENT) == (unsigned)(G - 1)) ? 1u : 0u;
        __syncthreads();
        if (bst[2]) {
            const int t = threadIdx.x;
            if (t < 16) { g_bar[XB_XCNT(t)] = 0u; g_bar[XB_XSUB(t)] = 0u; g_bar[XB_XGEN(t)] = 0u; }
            if (t == 16) { g_bar[XB_TOP] = 0u; g_bar[XB_TOPGEN] = 0u; g_bar[XB_TMO] = 0u; g_bar[XB_DONE] = 0u; }
        }
    }
#ifdef PROBE_SYNC
    for (int q_ = 0; q_ < 8; ++q_) xcd_barrier(xbar);
#endif
#undef IN
#undef SEAM
}

extern "C" void kernel_launch(void* const* d_in, const int* in_sizes, int n_in, void* d_out, int out_size, void* d_ws, size_t ws_size, hipStream_t stream) {
    static int grid = 0;
    if (grid == 0) {
        int dev = 0, cus = 0, per_cu = 0;
        hipGetDevice(&dev);
        hipDeviceGetAttribute(&cus, hipDeviceAttributeMultiprocessorCount, dev);
        if (hipFuncSetAttribute((const void*)mk_fwd, hipFuncAttributeMaxDynamicSharedMemorySize, LDS_BYTES) != hipSuccess) fprintf(stderr, "kernel_launch: hipFuncSetAttribute failed\n");
        if (hipOccupancyMaxActiveBlocksPerMultiprocessor(&per_cu, (const void*)mk_fwd, 512, LDS_BYTES) != hipSuccess || per_cu < 1) { fprintf(stderr, "kernel_launch: occupancy query gave %d\n", per_cu); per_cu = 1; }
        (void)hipGetLastError();
        grid = cus * per_cu; if (grid > 256) grid = 256;
        if (n_in != 23 || ws_size < WS_END) { fprintf(stderr, "kernel_launch: unexpected n_in %d / ws %zu\n", n_in, ws_size); }
    }
    Args a{};
    for (int i = 0; i < 23; ++i) a.in[i] = (const float*)d_in[i];
    a.out = (float*)d_out; a.ws = (unsigned char*)d_ws;
#if MK_MULTI
    for (int ph = 0; ph < 9; ++ph) { a.ph_lo = ph; a.ph_hi = ph + 1; a.coop = 0; hipLaunchKernelGGL(mk_fwd, dim3(grid), dim3(512), LDS_BYTES, stream, a); }
#else
    for (int ph = 0; ph <= PROBE_PREFIX; ++ph) { a.ph_lo = ph; a.ph_hi = ph + 1; a.coop = 0; hipLaunchKernelGGL(mk_fwd, dim3(grid), dim3(512), LDS_BYTES, stream, a); }
    a.ph_lo = 0; a.ph_hi = 9; a.coop = 1; a.pad = PROBE_REPS;
    void* args[] = {&a};
    hipError_t e = hipLaunchCooperativeKernel((const void*)mk_fwd, dim3(grid), dim3(512), args, LDS_BYTES, stream);
    if (e != hipSuccess) fprintf(stderr, "cooperative launch failed: %s (grid %d)\n", hipGetErrorString(e), grid);
#endif
}
```
